# Optimizing an MI355X kernel written in HIP

```python
import jax, jax.numpy as jnp
from jax import lax
import numpy as np

D_MODEL = 2048
BATCH = 4
SEQ = 8192
DEPTH = 1

D_PLE = 256
RMS_EPS = 1e-6
POOL_WINDOWS = (2, 4, 8, 16)
N_POOL_GROUPS = 4
POOL_GROUP_DIM = 128
D_POOL = N_POOL_GROUPS * POOL_GROUP_DIM
N_HEADS = 12
QK_NOPE_DIM = 128
QK_ROPE_DIM = 64
QK_HEAD_DIM = QK_NOPE_DIM + QK_ROPE_DIM
V_HEAD_DIM = 128
Q_LORA_RANK = 512
KV_LORA_RANK = 512
D_ATTN = N_HEADS * V_HEAD_DIM
ROPE_THETA = 10000.0
Q_BLOCK = 128
D_MIX = D_POOL + D_ATTN
D_IN = D_POOL + Q_LORA_RANK + KV_LORA_RANK + QK_ROPE_DIM
PEER_HEADS = 8
PEER_N_KEYS = 128
PEER_N_EXPERTS = PEER_N_KEYS * PEER_N_KEYS
PEER_TOPK = 16
PEER_HALF_DIM = 128
PEER_QUERY_DIM = 2 * PEER_HALF_DIM
PEER_TOKEN_CHUNK = 128
PEER_V_SCALE = 0.5

kernel_name = "hymba_pool_mla_peer_block"


def rmsnorm(x, g):
    xf = x.astype(jnp.float32)
    y = xf * lax.rsqrt(jnp.mean(xf * xf, axis=-1, keepdims=True) + RMS_EPS)
    return (y * g.astype(jnp.float32)).astype(x.dtype)


def rope_tables(positions):
    inv_freq = ROPE_THETA ** (-jnp.arange(0, QK_ROPE_DIM, 2, dtype=jnp.float32) / QK_ROPE_DIM)
    ang = positions.astype(jnp.float32)[..., None] * inv_freq
    return jnp.cos(ang), jnp.sin(ang)


def apply_rope(x, cos, sin):
    half = x.shape[-1] // 2
    x1, x2 = x[..., :half], x[..., half:]
    c = cos.astype(x.dtype)
    s = sin.astype(x.dtype)
    return jnp.concatenate([x1 * c - x2 * s, x2 * c + x1 * s], axis=-1)


def pool_mixer(xp, pool_w, pool_scale):
    b, s, _ = xp.shape
    xg = xp.astype(jnp.float32).reshape(b, s, N_POOL_GROUPS, POOL_GROUP_DIM)
    csum = jnp.cumsum(xg, axis=1)
    t = jnp.arange(s)
    outs = []
    for gi, w in enumerate(POOL_WINDOWS):
        c = csum[:, :, gi]
        lag = jnp.pad(c[:, :s - w], ((0, 0), (w, 0), (0, 0)))
        cnt = jnp.minimum(t + 1, w).astype(jnp.float32)[None, :, None]
        outs.append((c - lag) / cnt - xg[:, :, gi])
    pooled = jnp.stack(outs, axis=2).astype(xp.dtype)
    mixed = jnp.einsum('bsgc,gcd->bsgd', pooled, pool_w).reshape(b, s, D_POOL)
    return mixed * pool_scale


def mla_attention(q_c, kv_c, k_r, q_norm_g, w_uq, kv_norm_g, w_ukv, cos, sin):
    b, s, _ = q_c.shape
    q = (rmsnorm(q_c, q_norm_g) @ w_uq).reshape(b, s, N_HEADS, QK_HEAD_DIM)
    q_nope = q[..., :QK_NOPE_DIM]
    q_rope = apply_rope(q[..., QK_NOPE_DIM:], cos[:, :, None], sin[:, :, None])
    kv = (rmsnorm(kv_c, kv_norm_g) @ w_ukv).reshape(b, s, N_HEADS, QK_NOPE_DIM + V_HEAD_DIM)
    k_nope = kv[..., :QK_NOPE_DIM]
    v = kv[..., QK_NOPE_DIM:]
    k_rope = apply_rope(k_r, cos, sin)
    scale = QK_HEAD_DIM ** -0.5
    outs = []
    for qb in range(s // Q_BLOCK):
        q0 = qb * Q_BLOCK
        kend = q0 + Q_BLOCK
        sc = (jnp.einsum('bqhd,bkhd->bhqk', q_nope[:, q0:kend], k_nope[:, :kend])
              + jnp.einsum('bqhr,bkr->bhqk', q_rope[:, q0:kend], k_rope[:, :kend]))
        sc = sc.astype(jnp.float32) * scale
        causal = jnp.arange(kend)[None, :] <= (q0 + jnp.arange(Q_BLOCK))[:, None]
        sc = jnp.where(causal, sc, jnp.float32(-1e30))
        pr = jax.nn.softmax(sc, axis=-1).astype(v.dtype)
        outs.append(jnp.einsum('bhqk,bkhd->bqhd', pr, v[:, :kend]))
    o = jnp.concatenate(outs, axis=1)
    return o.reshape(b, s, D_ATTN)


def peer_ffn(xn, wq, sub_keys, u, v):
    b, s, d = xn.shape
    t = b * s
    xt = xn.reshape(t, d)
    q = (xt @ wq).reshape(t, PEER_HEADS, 2, PEER_HALF_DIM)
    sc = jnp.einsum('thpc,hpnc->thpn', q, sub_keys).astype(jnp.float32)
    top_v, top_i = lax.top_k(sc, PEER_TOPK)
    kk = PEER_TOPK * PEER_TOPK
    cand_v = (top_v[:, :, 0, :, None] + top_v[:, :, 1, None, :]).reshape(t, PEER_HEADS, kk)
    cand_id = (top_i[:, :, 0, :, None] * PEER_N_KEYS + top_i[:, :, 1, None, :]).reshape(t, PEER_HEADS, kk)
    best_v, best_pos = lax.top_k(cand_v, PEER_TOPK)
    expert = jnp.take_along_axis(cand_id, best_pos, axis=-1)
    gate = jax.nn.softmax(best_v, axis=-1).astype(xn.dtype)
    n_chunks = t // PEER_TOKEN_CHUNK

    def chunk_fn(args):
        xc, ec, gc = args
        hc = jnp.einsum('cd,chkd->chk', xc, u[ec])
        ac = gc * jax.nn.gelu(hc)
        return jnp.einsum('chk,chkd->cd', ac, v[ec])

    out = lax.map(chunk_fn, (
        xt.reshape(n_chunks, PEER_TOKEN_CHUNK, d),
        expert.reshape(n_chunks, PEER_TOKEN_CHUNK, PEER_HEADS, PEER_TOPK),
        gate.reshape(n_chunks, PEER_TOKEN_CHUNK, PEER_HEADS, PEER_TOPK)))
    return out.reshape(b, s, d)


def setup_inputs(seed: int = 0) -> dict:
    key = jax.random.key(seed)
    ks = jax.random.split(key, 24)
    f32 = jnp.float32
    nrm = lambda k, shape, sc: jax.random.normal(k, shape, f32) * sc
    gain = lambda k, shape: 1.0 + 0.02 * jax.random.normal(k, shape, f32)
    L = DEPTH
    return {
        "x": jax.random.normal(ks[0], (BATCH, SEQ, D_MODEL), f32),
        "p": jax.random.normal(ks[1], (DEPTH, BATCH, SEQ, D_PLE), f32),
        "positions": jnp.broadcast_to(jnp.arange(SEQ, dtype=jnp.int32), (BATCH, SEQ)),
        "mix_norm_g": gain(ks[2], (L, D_MODEL)),
        "w_in": nrm(ks[3], (L, D_MODEL, D_IN), D_MODEL ** -0.5),
        "pool_w": nrm(ks[4], (L, N_POOL_GROUPS, POOL_GROUP_DIM, POOL_GROUP_DIM), POOL_GROUP_DIM ** -0.5),
        "pool_scale": gain(ks[5], (L, D_POOL)),
        "q_norm_g": gain(ks[6], (L, Q_LORA_RANK)),
        "w_uq": nrm(ks[7], (L, Q_LORA_RANK, N_HEADS * QK_HEAD_DIM), Q_LORA_RANK ** -0.5),
        "kv_norm_g": gain(ks[8], (L, KV_LORA_RANK)),
        "w_ukv": nrm(ks[9], (L, KV_LORA_RANK, N_HEADS * (QK_NOPE_DIM + V_HEAD_DIM)), KV_LORA_RANK ** -0.5),
        "w_o": nrm(ks[10], (L, D_MIX, D_MODEL), D_MIX ** -0.5),
        "ffn_norm_g": gain(ks[11], (L, D_MODEL)),
        "peer_wq": nrm(ks[12], (L, D_MODEL, PEER_HEADS * PEER_QUERY_DIM), D_MODEL ** -0.5),
        "peer_sub_keys": nrm(ks[13], (L, PEER_HEADS, 2, PEER_N_KEYS, PEER_HALF_DIM), PEER_HALF_DIM ** -0.5),
        "peer_u": nrm(ks[14], (L, PEER_N_EXPERTS, D_MODEL), D_MODEL ** -0.5),
        "peer_v": nrm(ks[15], (L, PEER_N_EXPERTS, D_MODEL), PEER_V_SCALE),
        "ple_norm_g": gain(ks[16], (L, D_MODEL)),
        "ple_w_gate": nrm(ks[17], (L, D_MODEL, D_MODEL), D_MODEL ** -0.5),
        "ple_w_proj": nrm(ks[18], (L, D_PLE, D_MODEL), D_PLE ** -0.5),
        "final_norm_g": gain(ks[19], (D_MODEL,)),
    }


def reference(x, p, positions, mix_norm_g, w_in, pool_w, pool_scale, q_norm_g, w_uq,
              kv_norm_g, w_ukv, w_o, ffn_norm_g, peer_wq, peer_sub_keys, peer_u, peer_v,
              ple_norm_g, ple_w_gate, ple_w_proj, final_norm_g):
    cos, sin = rope_tables(positions)
    h = x
    o1 = D_POOL
    o2 = o1 + Q_LORA_RANK
    o3 = o2 + KV_LORA_RANK
    for i in range(DEPTH):
        z = rmsnorm(h, mix_norm_g[i]) @ w_in[i]
        y_pool = pool_mixer(z[..., :o1], pool_w[i], pool_scale[i])
        y_attn = mla_attention(z[..., o1:o2], z[..., o2:o3], z[..., o3:],
                               q_norm_g[i], w_uq[i], kv_norm_g[i], w_ukv[i], cos, sin)
        h = h + jnp.concatenate([y_pool, y_attn], axis=-1) @ w_o[i]
        h = h + peer_ffn(rmsnorm(h, ffn_norm_g[i]), peer_wq[i], peer_sub_keys[i], peer_u[i], peer_v[i])
        gate = jax.nn.sigmoid(rmsnorm(h, ple_norm_g[i]) @ ple_w_gate[i])
        h = h + gate * (p[i] @ ple_w_proj[i])
    return rmsnorm(h, final_norm_g)
```

```cpp
#include <hip/hip_runtime.h>
#include <hip/hip_cooperative_groups.h>
#include <cstdio>
#include <cstdint>
namespace cg = cooperative_groups;

#define LAS __attribute__((address_space(3)))
typedef unsigned short bf16_t;
typedef short bf16x8 __attribute__((ext_vector_type(8)));
typedef float f32x4 __attribute__((ext_vector_type(4)));
typedef float f32x2 __attribute__((ext_vector_type(2)));
typedef unsigned u32x4 __attribute__((ext_vector_type(4)));
typedef unsigned u32x2 __attribute__((ext_vector_type(2)));

constexpr int T = 32768, SEQ = 8192, NB = 4, D = 2048, DIN = 1600, DINP = 1792, DPOOL = 512, DPLE = 256;
constexpr int NH = 12, QKD = 192, NQ = NH * QKD  , NKV = NH * 256  , DATT = 1536;
constexpr int PH = 8, PK = 128, PTOP = 16, NEXP = 16384;
constexpr float EPS = 1e-6f;
constexpr int NWAVES = 8, NTHR = 512;

constexpr size_t MiB = 1u << 20;
constexpr size_t WS_CTL = 932 * MiB;
constexpr size_t WS_WIN = 1 * MiB;
constexpr size_t WS_WUQ = 8 * MiB;
constexpr size_t WS_WUKV = 11 * MiB;
constexpr size_t WS_WO = 14 * MiB;
constexpr size_t WS_WQ = 22 * MiB;
constexpr size_t WS_SK = 30 * MiB;
constexpr size_t WS_WG = 31 * MiB;
constexpr size_t WS_WP = 39 * MiB;
constexpr size_t WS_ROPE = 40 * MiB;
constexpr size_t WS_KR = 48 * MiB;
constexpr size_t WS_PB = 52 * MiB;
constexpr size_t WS_EID = 68 * MiB;
constexpr size_t WS_GATE = 84 * MiB;
constexpr size_t WS_UT = 100 * MiB;
constexpr size_t WS_VT = 164 * MiB;
constexpr size_t WS_AB = 228 * MiB;
constexpr size_t WS_Z = 356 * MiB;
constexpr size_t WS_Q = 468 * MiB;
constexpr size_t WS_KV = 612 * MiB;
constexpr size_t WS_AMIX = 804 * MiB;
constexpr size_t WS_END = 934 * MiB;

#define ATTN_ZERO 0
#define PEER_ON 1
constexpr int LDS_BYTES = 147456;

typedef __bf16 bf16x2_t __attribute__((ext_vector_type(2)));
__device__ __forceinline__ unsigned cvt_pk_bf16(float lo, float hi) { f32x2 v = {lo, hi}; bf16x2_t b = __builtin_convertvector(v, bf16x2_t); return __builtin_bit_cast(unsigned, b); }
__device__ __forceinline__ float bf_lo(unsigned w) { return __uint_as_float(w << 16); }
__device__ __forceinline__ float bf_hi(unsigned w) { return __uint_as_float(w & 0xffff0000u); }
__device__ __forceinline__ float wave_sum(float v) {
#pragma unroll
    for (int o = 1; o < 64; o <<= 1) v += __shfl_xor(v, o);
    return v;
}
#define LDS_WAIT() asm volatile("s_waitcnt lgkmcnt(0)" ::: "memory")
typedef unsigned long long u64;
__device__ __forceinline__ void ssq_add(u64* p, float ss) { atomicAdd(p, (u64)(ss * 1048576.f + 0.5f)); }
__device__ __forceinline__ float ssq_get(const u64* p) { return (float)(*p) * (1.f / 1048576.f); }

namespace pg8 {
constexpr int BM = 256, BK = 64, HALF = 128, HTB = HALF * BK * 2, STAGE_BYTES = 8 * HTB, NXCD = 8, WGM = 8;
__host__ __device__ __forceinline__ int lds_byte(int r, int c) { const int st = (r >> 4) * 2 + (c >> 5), rr = r & 15, cc = c & 31, ob = rr * 64 + cc * 2; return st * 1024 + (ob ^ (((ob >> 9) & 1) << 5)); }
__host__ __device__ __forceinline__ void stage_rc(int b, int& R, int& C) { const int st = b / 1024, sb = b % 1024, swz = sb ^ (((sb >> 9) & 1) << 5); R = (st >> 1) * 16 + swz / 64; C = (st & 1) * 32 + (swz % 64) / 2; }
__host__ __device__ __forceinline__ int perm32(int rho) { const int n = rho >> 4, i = rho & 15; return 8 * (i >> 2) + 4 * n + (i & 3); }

struct Unit { int pm, pn; };
struct Gemm { const bf16_t* A; const bf16_t* Bt; int lda, ldb, K, acol_pn; };

struct StaticOrder {
    int nM, nN, nwg, G, c;
    __device__ void init(int nM_, int nN_, int G_, int c_) { nM = nM_; nN = nN_; nwg = nM * nN; G = G_; c = c_; }
    __device__ bool next(int i, Unit& u) const {
        const long L = (long)i * G + c; if (L >= nwg) return false;
        int wgid = (int)L; { const int q = nwg / NXCD, r = nwg % NXCD, xcd = wgid % NXCD, off = wgid / NXCD; wgid = (xcd < r ? xcd * (q + 1) : r * (q + 1) + (xcd - r) * q) + off; }
        const int nig = WGM * nN, gid = wgid / nig, fm = gid * WGM, gsz = (nM - fm) < WGM ? (nM - fm) : WGM;
        u.pm = fm + ((wgid % nig) % gsz); u.pn = (wgid % nig) / gsz; return true;
    }
};
struct SingleUnit {
    Unit u0;
    __device__ bool next(int i, Unit& u) const { if (i > 0) return false; u = u0; return true; }
};

template <class Epi, class Sched, bool ALIGN_EPI, bool SP2>
__device__ __forceinline__ void gemm_phase(LAS unsigned char* lds, const Gemm g, const Sched& S, const Epi& E) {
    const int tid = threadIdx.x, wid = __builtin_amdgcn_readfirstlane(tid >> 6), lane = tid & 63, wr = wid >> 2, wc = wid & 3, fr = lane & 15, fq = lane >> 4;
    int K_ = g.K; asm volatile("" : "+s"(K_));
    const int K = K_, nt = K / BK;
    unsigned voffA[2], voffB[2];
#pragma unroll
    for (int i = 0; i < 2; ++i) { int R, C; stage_rc(tid * 16 + i * 8192, R, C); const int Rb = Epi::PERM ? ((R & ~31) + perm32(R & 31)) : R;
        voffA[i] = (unsigned)(R * g.lda + C) * 2u; voffB[i] = (unsigned)(Rb * g.ldb + C) * 2u; }
    const size_t kstep = (size_t)(BK * 2);
    const size_t hstepA = (size_t)HALF * g.lda * 2, hstepB = (size_t)HALF * g.ldb * 2;
    const size_t tstepA = 2 * hstepA, tstepB = 2 * hstepB;
    const unsigned ldsw = (unsigned)wid * 1024u;
    const int aoff = lds_byte(wr * 64 + fr, fq * 8), boff = lds_byte(wc * 32 + fr, fq * 8);
#define PG8_SA(b, h) (((b) * 2 + (h)) * HTB)
#define PG8_SB(b, h) ((4 + (b) * 2 + (h)) * HTB)
#define PG8_STAGE(bufoff, gbase, voff) do { _Pragma("unroll") for (int _i = 0; _i < 2; ++_i) \
        __builtin_amdgcn_global_load_lds((const unsigned*)((const char*)(gbase) + (voff)[_i]), (LAS unsigned*)(lds + (bufoff) + ldsw + _i * 8192), 16, 0, 0); } while (0)
#define PG8_LDA(dst, b, h) do { _Pragma("unroll") for (int m = 0; m < 4; ++m) _Pragma("unroll") for (int k = 0; k < 2; ++k) dst[m][k] = *(const LAS bf16x8*)(lds + PG8_SA(b, h) + aoff + m * 2048 + k * 1024); } while (0)
#define PG8_LDB(dst, b, h) do { _Pragma("unroll") for (int n = 0; n < 2; ++n) _Pragma("unroll") for (int k = 0; k < 2; ++k) dst[n][k] = *(const LAS bf16x8*)(lds + PG8_SB(b, h) + boff + n * 2048 + k * 1024); } while (0)
#define PG8_MMA(ai, bj, At, Bt) do { __builtin_amdgcn_s_setprio(1); _Pragma("unroll") for (int m = 0; m < 4; ++m) _Pragma("unroll") for (int n = 0; n < 2; ++n) _Pragma("unroll") for (int k = 0; k < 2; ++k) \
        acc[ai][bj][m][n] = __builtin_amdgcn_mfma_f32_16x16x32_bf16(Bt[n][k], At[m][k], acc[ai][bj][m][n], 0, 0, 0); __builtin_amdgcn_s_setprio(0); } while (0)
#define PG8_WAIT_V(n) asm volatile("s_waitcnt vmcnt(" #n ")" ::: "memory")
#define PG8_WAIT_L(n) asm volatile("s_waitcnt lgkmcnt(" #n ")" ::: "memory")
#define PG8_BAR __builtin_amdgcn_s_barrier()
#define PG8_SCHED __builtin_amdgcn_sched_barrier(0)
    Unit cur, nxt; int ui = 0;
    if (!S.next(0, cur)) return;
    f32x4 acc[2][2][4][2];
#pragma unroll
    for (int a = 0; a < 2; ++a)
#pragma unroll
        for (int b = 0; b < 2; ++b)
#pragma unroll
            for (int m = 0; m < 4; ++m)
#pragma unroll
                for (int n = 0; n < 2; ++n) acc[a][b][m][n] = (f32x4){0.f, 0.f, 0.f, 0.f};
    bf16x8 At[4][2], B0[2][2], B1[2][2];
    const char* cA = (const char*)g.A + (size_t)cur.pm * tstepA + (size_t)cur.pn * g.acol_pn * 2; const char* cB = (const char*)g.Bt + (size_t)cur.pn * tstepB;
    if constexpr (SP2) {
        PG8_STAGE(PG8_SB(0, 0), cB, voffB); PG8_STAGE(PG8_SB(0, 1), cB + hstepB, voffB); PG8_STAGE(PG8_SA(0, 0), cA, voffA); PG8_STAGE(PG8_SA(0, 1), cA + hstepA, voffA);
        if (wr == 1) PG8_BAR;
        PG8_WAIT_V(2); PG8_BAR;
        PG8_STAGE(PG8_SB(1, 0), cB + kstep, voffB); PG8_STAGE(PG8_SA(1, 0), cA + kstep, voffA); PG8_STAGE(PG8_SB(1, 1), cB + hstepB + kstep, voffB);
        PG8_WAIT_V(6); PG8_BAR;
    } else {
        PG8_STAGE(PG8_SB(0, 0), cB, voffB); PG8_STAGE(PG8_SA(0, 0), cA, voffA); PG8_STAGE(PG8_SB(0, 1), cB + hstepB, voffB); PG8_STAGE(PG8_SA(0, 1), cA + hstepA, voffA);
        if (wr == 1) PG8_BAR;
        PG8_WAIT_V(4); PG8_BAR;
        PG8_STAGE(PG8_SB(1, 0), cB + kstep, voffB); PG8_STAGE(PG8_SA(1, 0), cA + kstep, voffA); PG8_STAGE(PG8_SB(1, 1), cB + hstepB + kstep, voffB);
        PG8_WAIT_V(6); PG8_BAR;
    }
    for (;;) {
        const bool has_next = S.next(ui + 1, nxt);
        const char* nA = has_next ? (const char*)g.A + (size_t)nxt.pm * tstepA + (size_t)nxt.pn * g.acol_pn * 2 : cA; const char* nB = has_next ? (const char*)g.Bt + (size_t)nxt.pn * tstepB : cB;
        for (int t = 0; t < nt; t += 2) {
            const bool last = (t == nt - 2);
            const char* a1 = cA + (size_t)(t + 1) * kstep;
            const char* a2 = last ? nA : cA + (size_t)(t + 2) * kstep; const char* b2 = last ? nB : cB + (size_t)(t + 2) * kstep;
            const char* a3 = a2 + kstep; const char* b3 = b2 + kstep;
            if constexpr (SP2) {
            PG8_LDB(B0, 0, 0); PG8_LDB(B1, 0, 1); PG8_SCHED; PG8_LDA(At, 0, 0); PG8_STAGE(PG8_SA(1, 1), a1 + hstepA, voffA);
            PG8_WAIT_V(8); PG8_WAIT_L(0); PG8_BAR; PG8_MMA(0, 0, At, B0); PG8_MMA(0, 1, At, B1); PG8_BAR; PG8_SCHED;
            PG8_LDA(At, 0, 1); PG8_STAGE(PG8_SB(0, 0), b2, voffB); PG8_STAGE(PG8_SB(0, 1), b2 + hstepB, voffB); PG8_STAGE(PG8_SA(0, 0), a2, voffA);
            PG8_WAIT_V(8); PG8_WAIT_L(0); PG8_BAR; PG8_MMA(1, 0, At, B0); PG8_MMA(1, 1, At, B1); PG8_BAR; PG8_SCHED;
            PG8_LDB(B0, 1, 0); PG8_LDB(B1, 1, 1); PG8_SCHED; PG8_LDA(At, 1, 0); PG8_STAGE(PG8_SA(0, 1), a2 + hstepA, voffA);
            PG8_WAIT_V(8); PG8_WAIT_L(0); PG8_BAR; PG8_MMA(0, 0, At, B0); PG8_MMA(0, 1, At, B1); PG8_BAR; PG8_SCHED;
            PG8_LDA(At, 1, 1); PG8_STAGE(PG8_SB(1, 0), b3, voffB); PG8_STAGE(PG8_SB(1, 1), b3 + hstepB, voffB); PG8_STAGE(PG8_SA(1, 0), a3, voffA);
            PG8_WAIT_V(8); PG8_WAIT_L(0); PG8_BAR; PG8_MMA(1, 0, At, B0); PG8_MMA(1, 1, At, B1); PG8_BAR; PG8_SCHED;
            } else {
            PG8_LDB(B0, 0, 0); PG8_SCHED; PG8_LDA(At, 0, 0); PG8_STAGE(PG8_SA(1, 1), a1 + hstepA, voffA);
            PG8_WAIT_L(8); PG8_BAR; PG8_WAIT_L(0); PG8_MMA(0, 0, At, B0); PG8_BAR; PG8_SCHED;
            PG8_LDB(B1, 0, 1); PG8_STAGE(PG8_SB(0, 0), b2, voffB);
            PG8_BAR; PG8_WAIT_L(0); PG8_MMA(0, 1, At, B1); PG8_BAR;
            PG8_LDA(At, 0, 1); PG8_STAGE(PG8_SA(0, 0), a2, voffA);
            PG8_BAR; PG8_WAIT_L(0); PG8_MMA(1, 0, At, B0); PG8_BAR; PG8_SCHED;
            PG8_STAGE(PG8_SB(0, 1), b2 + hstepB, voffB);
            PG8_WAIT_V(6); PG8_BAR; PG8_MMA(1, 1, At, B1); PG8_BAR;
            PG8_LDB(B0, 1, 0); PG8_SCHED; PG8_LDA(At, 1, 0); PG8_STAGE(PG8_SA(0, 1), a2 + hstepA, voffA);
            PG8_WAIT_L(8); PG8_BAR; PG8_WAIT_L(0); PG8_MMA(0, 0, At, B0); PG8_BAR; PG8_SCHED;
            PG8_LDB(B1, 1, 1); PG8_STAGE(PG8_SB(1, 0), b3, voffB);
            PG8_BAR; PG8_WAIT_L(0); PG8_MMA(0, 1, At, B1); PG8_BAR;
            PG8_LDA(At, 1, 1); PG8_STAGE(PG8_SA(1, 0), a3, voffA);
            PG8_BAR; PG8_WAIT_L(0); PG8_MMA(1, 0, At, B0); PG8_BAR; PG8_SCHED;
            PG8_STAGE(PG8_SB(1, 1), b3 + hstepB, voffB);
            PG8_WAIT_V(6); PG8_BAR; PG8_MMA(1, 1, At, B1); PG8_BAR;
            }
        }
        if constexpr (ALIGN_EPI) { if (wr == 0) PG8_BAR; }
        if constexpr (!Epi::AFTER_DRAIN) { E(acc, cur, wr, wc, fr, fq); }
        if (!has_next) break;
#pragma unroll
        for (int a = 0; a < 2; ++a)
#pragma unroll
            for (int b = 0; b < 2; ++b)
#pragma unroll
                for (int m = 0; m < 4; ++m)
#pragma unroll
                    for (int n = 0; n < 2; ++n) acc[a][b][m][n] = (f32x4){0.f, 0.f, 0.f, 0.f};
        cur = nxt; cA = nA; cB = nB; ++ui;
        if constexpr (ALIGN_EPI) { if (wr == 1) PG8_BAR; }
    }
    PG8_WAIT_V(0);
    if constexpr (!ALIGN_EPI) { if (wr == 0) PG8_BAR; }
    PG8_BAR;
    if constexpr (Epi::AFTER_DRAIN) { E.fused(acc, cur, wr, wc, fr, fq, lds, wid, lane); }
#undef PG8_SA
#undef PG8_SB
#undef PG8_STAGE
#undef PG8_LDA
#undef PG8_LDB
#undef PG8_MMA
#undef PG8_WAIT_V
#undef PG8_WAIT_L
#undef PG8_BAR
#undef PG8_SCHED
}


template <int LDC, bool RS, bool SSQ, bool ROPE> struct EpiBf16 {
    static constexpr bool PERM = true, AFTER_DRAIN = false;
    bf16_t* O; const u64* ssq_in; float inv_n, mul; u64* ssq_a; u64* ssq_b; const float* rope;
    __device__ __forceinline__ void operator()(const f32x4 (&acc)[2][2][4][2], const Unit& u, int wr, int wc, int fr, int fq) const {
        const int row0 = u.pm * BM + wr * 64 + fr, col0 = u.pn * BM + wc * 32 + 8 * fq;
        const bool do_ssq = SSQ && u.pn >= 2 && u.pn < 6;
#pragma unroll
        for (int ai = 0; ai < 2; ++ai)
#pragma unroll
            for (int m = 0; m < 4; ++m) {
                const int row = row0 + ai * HALF + m * 16;
                float sc = mul; if constexpr (RS) sc *= rsqrtf(ssq_get(ssq_in + row) * inv_n + EPS);
                float ss = 0.f;
#pragma unroll
                for (int bj = 0; bj < 2; ++bj) {
                    f32x4 v0 = acc[ai][bj][m][0] * sc, v1 = acc[ai][bj][m][1] * sc; const int col = col0 + bj * HALF;
                    if constexpr (ROPE) { const int cw = col % QKD;
                        if (cw >= 128) { const int i0 = (cw - 128) >> 1; const f32x4 cs = *(const f32x4*)(rope + (size_t)row * 64 + i0), sn = *(const f32x4*)(rope + (size_t)row * 64 + 32 + i0);
                            f32x4 a, b;
                            a[0] = v0[0] * cs[0] - v0[1] * sn[0]; a[1] = v0[1] * cs[0] + v0[0] * sn[0]; a[2] = v0[2] * cs[1] - v0[3] * sn[1]; a[3] = v0[3] * cs[1] + v0[2] * sn[1];
                            b[0] = v1[0] * cs[2] - v1[1] * sn[2]; b[1] = v1[1] * cs[2] + v1[0] * sn[2]; b[2] = v1[2] * cs[3] - v1[3] * sn[3]; b[3] = v1[3] * cs[3] + v1[2] * sn[3];
                            v0 = a; v1 = b; } }
                    if constexpr (SSQ) ss += (v0[0] * v0[0] + v0[1] * v0[1]) + (v0[2] * v0[2] + v0[3] * v0[3]) + (v1[0] * v1[0] + v1[1] * v1[1]) + (v1[2] * v1[2] + v1[3] * v1[3]);
                    u32x4 w; w.x = cvt_pk_bf16(v0[0], v0[1]); w.y = cvt_pk_bf16(v0[2], v0[3]); w.z = cvt_pk_bf16(v1[0], v1[1]); w.w = cvt_pk_bf16(v1[2], v1[3]);
                    *(u32x4*)(O + (size_t)row * LDC + col) = w;
                }
                if constexpr (SSQ) { if (do_ssq) { ss += __shfl_xor(ss, 16); ss += __shfl_xor(ss, 32); if (fq == 0) ssq_add((u.pn < 4 ? ssq_a : ssq_b) + row, ss); } }
                asm volatile("" ::: "memory");
            }
    }
};

struct EpiResF32 {
    static constexpr bool PERM = false, AFTER_DRAIN = false;
    const float* resid; float* outF; bf16_t* outB; u64* ssq;
    __device__ __forceinline__ void operator()(const f32x4 (&acc)[2][2][4][2], const Unit& u, int wr, int wc, int fr, int fq) const {
        const int row0 = u.pm * BM + wr * 64 + fr, col0 = u.pn * BM + wc * 32 + 4 * fq;
#pragma unroll
        for (int ai = 0; ai < 2; ++ai)
#pragma unroll
            for (int m = 0; m < 4; ++m) {
                const int row = row0 + ai * HALF + m * 16; const size_t off = (size_t)row * D + col0; float ss = 0.f;
#pragma unroll
                for (int bj = 0; bj < 2; ++bj)
#pragma unroll
                    for (int n = 0; n < 2; ++n) { const size_t o = off + bj * HALF + n * 16; const f32x4 v = *(const f32x4*)(resid + o) + acc[ai][bj][m][n];
                        *(f32x4*)(outF + o) = v; u32x2 w; w.x = cvt_pk_bf16(v[0], v[1]); w.y = cvt_pk_bf16(v[2], v[3]); *(u32x2*)(outB + o) = w;
                        ss += (v[0] * v[0] + v[1] * v[1]) + (v[2] * v[2] + v[3] * v[3]); }
                ss += __shfl_xor(ss, 16); ss += __shfl_xor(ss, 32); if (fq == 0) ssq_add(ssq + row, ss);
                asm volatile("" ::: "memory");
            }
    }
};

struct EpiPle {
    static constexpr bool PERM = false, AFTER_DRAIN = false;
    float* hio; const bf16_t* proj; const float* rinv; u64* ssq;
    __device__ __forceinline__ void operator()(const f32x4 (&acc)[2][2][4][2], const Unit& u, int wr, int wc, int fr, int fq) const {
        const int row0 = u.pm * BM + wr * 64 + fr, col0 = u.pn * BM + wc * 32 + 4 * fq;
#pragma unroll
        for (int ai = 0; ai < 2; ++ai)
#pragma unroll
            for (int m = 0; m < 4; ++m) {
                const int row = row0 + ai * HALF + m * 16; const size_t off = (size_t)row * D + col0; float ss = 0.f; const float ri = rinv[row];
#pragma unroll
                for (int bj = 0; bj < 2; ++bj)
#pragma unroll
                    for (int n = 0; n < 2; ++n) { const size_t o = off + bj * HALF + n * 16; const f32x4 h = *(const f32x4*)(hio + o); const u32x2 pw = *(const u32x2*)(proj + o);
                        const f32x4 a = acc[ai][bj][m][n] * ri; f32x4 v;
                        v[0] = h[0] + bf_lo(pw.x) / (1.f + __expf(-a[0])); v[1] = h[1] + bf_hi(pw.x) / (1.f + __expf(-a[1]));
                        v[2] = h[2] + bf_lo(pw.y) / (1.f + __expf(-a[2])); v[3] = h[3] + bf_hi(pw.y) / (1.f + __expf(-a[3]));
                        *(f32x4*)(hio + o) = v; ss += (v[0] * v[0] + v[1] * v[1]) + (v[2] * v[2] + v[3] * v[3]); }
                ss += __shfl_xor(ss, 16); ss += __shfl_xor(ss, 32); if (fq == 0) ssq_add(ssq + row, ss);
                asm volatile("" ::: "memory");
            }
    }
};

__device__ __forceinline__ unsigned mono(float v) { const unsigned u = __float_as_uint(v); return (u & 0x80000000u) ? ~u : (u | 0x80000000u); }
__device__ __forceinline__ float unmono(unsigned k) { return (k & 0x80000000u) ? __uint_as_float(k ^ 0x80000000u) : __uint_as_float(~k); }
__device__ __forceinline__ void ins16(unsigned (&L)[16], unsigned x) {
#pragma unroll
    for (int i = 0; i < 16; ++i) { const unsigned hi = L[i] > x ? L[i] : x; x = L[i] > x ? x : L[i]; L[i] = hi; }
}
struct EpiTopK {
    static constexpr bool PERM = false, AFTER_DRAIN = true;
    int* eid; float* gate;
    __device__ __forceinline__ void fused(f32x4 (&acc)[2][2][4][2], const Unit& u, int wr, int wc, int fr, int fq, LAS unsigned char* lds, int wid, int lane) const {
        LAS float* SL = (LAS float*)lds;
        LAS unsigned char* TAB = lds + 512 * 272;
        const int tid = wid * 64 + lane, half = tid & 1, pp = (tid >> 1) & 1, rowl = tid >> 2;
#pragma unroll
        for (int ai = 0; ai < 2; ++ai) {
#pragma unroll
            for (int m = 0; m < 4; ++m)
#pragma unroll
                for (int bj = 0; bj < 2; ++bj)
#pragma unroll
                    for (int n = 0; n < 2; ++n) { const int r = 64 * wr + 16 * m + fr, c = 32 * wc + 16 * n + 4 * fq; const int list = r * 4 + bj * 2 + (c >> 6);
                        *(LAS f32x4*)(SL + list * 68 + (c & 63)) = acc[ai][bj][m][n]; }
            asm volatile("s_waitcnt lgkmcnt(0)" ::: "memory"); __builtin_amdgcn_s_barrier(); asm volatile("" ::: "memory");
            unsigned L[16];
#pragma unroll
            for (int i = 0; i < 16; ++i) L[i] = 0u;
            { const LAS float* mine = SL + tid * 68; const int ib = 127 - half * 64;
#pragma unroll 2
              for (int k4 = 0; k4 < 16; ++k4) { const f32x4 v = *(const LAS f32x4*)(mine + 4 * k4);
#pragma unroll
                  for (int e = 0; e < 4; ++e) ins16(L, (mono(v[e]) & ~127u) | (unsigned)(ib - 4 * k4 - e)); } }
            unsigned M[16];
#pragma unroll
            for (int i = 0; i < 16; ++i) { const unsigned o = (unsigned)__shfl_xor((int)L[15 - i], 1); M[i] = L[i] > o ? L[i] : o; }
#pragma unroll
            for (int st = 8; st >= 1; st >>= 1)
#pragma unroll
                for (int i = 0; i < 16; ++i) if (!(i & st)) { const unsigned hi = M[i] > M[i + st] ? M[i] : M[i + st], lo2 = M[i] > M[i + st] ? M[i + st] : M[i]; M[i] = hi; M[i + st] = lo2; }
            if (half == 0) {
#pragma unroll
                for (int i = 0; i < 16; ++i) TAB[(rowl * 2 + pp) * 16 + i] = (unsigned char)(127u - (M[i] & 127u)); }
            float va[16], vb[16];
#pragma unroll
            for (int i = 0; i < 16; ++i) { const unsigned o = (unsigned)__shfl_xor((int)M[i], 2); va[i] = unmono(M[i] & ~127u); vb[i] = unmono(o & ~127u); }
            unsigned C[16];
#pragma unroll
            for (int i = 0; i < 16; ++i) C[i] = 0u;
#pragma unroll
            for (int x = 0; x < 16; ++x)
#pragma unroll
                for (int y = 0; y < 16; ++y) if ((x + 1) * (y + 1) <= 16) ins16(C, (mono(va[x] + vb[y]) & ~255u) | (unsigned)(255 - (x * 16 + y)));
            asm volatile("s_waitcnt lgkmcnt(0)" ::: "memory");
            if ((tid & 3) == 0) {
                const int token = u.pm * BM + ai * HALF + rowl; const size_t ob = (size_t)token * 128 + u.pn * 16;
                const float vmax = unmono(C[0] & ~255u); float ex[16], sum = 0.f; int ee[16];
#pragma unroll
                for (int k = 0; k < 16; ++k) { ex[k] = __expf(unmono(C[k] & ~255u) - vmax); sum += ex[k]; const unsigned code = 255u - (C[k] & 255u);
                    ee[k] = (int)TAB[(rowl * 2 + 0) * 16 + (code >> 4)] * 128 + (int)TAB[(rowl * 2 + 1) * 16 + (code & 15u)]; }
                const float is = 1.f / sum;
#pragma unroll
                for (int k4 = 0; k4 < 4; ++k4) { *(f32x4*)(gate + ob + 4 * k4) = (f32x4){ex[4 * k4] * is, ex[4 * k4 + 1] * is, ex[4 * k4 + 2] * is, ex[4 * k4 + 3] * is};
                    *(u32x4*)(eid + ob + 4 * k4) = (u32x4){(unsigned)ee[4 * k4], (unsigned)ee[4 * k4 + 1], (unsigned)ee[4 * k4 + 2], (unsigned)ee[4 * k4 + 3]}; }
            }
            asm volatile("s_waitcnt lgkmcnt(0)" ::: "memory"); __builtin_amdgcn_s_barrier(); asm volatile("" ::: "memory");
        }
    }
};
}


namespace att {
typedef short s16x4 __attribute__((ext_vector_type(4)));
typedef float f32x16 __attribute__((ext_vector_type(16)));
constexpr int KVBLK = 64, SHM_V = 16384, SHM_KN = 16384, SHM_KR = 8192;
constexpr int OFF_KN = 0, OFF_KR = 2 * SHM_KN, OFF_V = OFF_KR + 2 * SHM_KR, OFF_WS = OFF_V + 2 * SHM_V, LDS_NEED = OFF_WS + NWAVES * 64 * 4;
#define KSWZ(row, colB) ((row) * 256 + ((colB) ^ (((row) & 7) << 4)))
#define KRSWZ(row, colB) ((row) * 128 + ((colB) ^ (((row) & 7) << 4)))
#define SBAR() __builtin_amdgcn_sched_barrier(0)
__device__ __forceinline__ int v_st(int k, int c) { const int kk = (k & ~0xC) | ((k & 4) << 1) | ((k & 8) >> 1); return ((kk >> 3) * 4 + (c >> 5)) * 512 + ((kk & 7) * 32 + (c & 31)) * 2; }
__device__ __forceinline__ int v_rd_base(int lane) { return ((lane & 3) << 3) | (((lane >> 2) & 3) << 6) | (((lane >> 4) & 1) << 5) | (((lane >> 5) & 1) << 8); }
constexpr int v_rd_off(int d0, int ks, int half) { return d0 * 512 + ks * 4096 + half * 2048; }
__device__ __forceinline__ int crow(int r, int hi) { return (r & 3) + 8 * (r >> 2) + 4 * hi; }
__device__ __forceinline__ unsigned cvtpk(float lo, float hi) { unsigned r; asm volatile("v_cvt_pk_bf16_f32 %0, %1, %2" : "=v"(r) : "v"(lo), "v"(hi)); return r; }
__device__ __forceinline__ void mask_tile(f32x16& p0, f32x16& p1, int dq) {
    const float NEG = -__builtin_inff();
#pragma unroll
    for (int r = 0; r < 16; ++r) { const int c = (r & 3) + 8 * (r >> 2); if (dq - c < 0) p0[r] = NEG; if (dq - c - 32 < 0) p1[r] = NEG; }
}
__device__ __forceinline__ void softmax_tile(f32x16& p0, f32x16& p1, float& m_reg, float& l_reg, float& alpha, bf16x8& pa0, bf16x8& pa1, bf16x8& pa2, bf16x8& pa3) {
    float pmax = p0[0];
#pragma unroll
    for (int r = 1; r < 16; ++r) pmax = fmaxf(pmax, p0[r]);
#pragma unroll
    for (int r = 0; r < 16; ++r) pmax = fmaxf(pmax, p1[r]);
    { auto rr = __builtin_amdgcn_permlane32_swap(__float_as_uint(pmax), __float_as_uint(pmax), false, false); pmax = fmaxf(__uint_as_float(rr[0]), __uint_as_float(rr[1])); }
    float mn;
    if (__builtin_expect(__all((pmax - m_reg) <= 8.f), 1)) { mn = m_reg; alpha = 1.f; }
    else { mn = fmaxf(m_reg, pmax); alpha = __builtin_amdgcn_exp2f(m_reg - mn); m_reg = mn; }
    float ps = 0.f;
#pragma unroll
    for (int r = 0; r < 16; ++r) { p0[r] = __builtin_amdgcn_exp2f(p0[r] - mn); ps += p0[r]; }
#pragma unroll
    for (int r = 0; r < 16; ++r) { p1[r] = __builtin_amdgcn_exp2f(p1[r] - mn); ps += p1[r]; }
    { auto rr = __builtin_amdgcn_permlane32_swap(__float_as_uint(ps), __float_as_uint(ps), false, false); ps = __uint_as_float(rr[0]) + __uint_as_float(rr[1]); }
    l_reg = l_reg * alpha + ps;
#define PK4(P, B_, OUT) do { unsigned a0 = cvtpk(P[B_+0], P[B_+1]), a1 = cvtpk(P[B_+2], P[B_+3]); unsigned b0 = cvtpk(P[B_+4], P[B_+5]), b1 = cvtpk(P[B_+6], P[B_+7]); \
        auto r0 = __builtin_amdgcn_permlane32_swap(a0, b0, false, false); auto r1 = __builtin_amdgcn_permlane32_swap(a1, b1, false, false); \
        u32x4 w = {r0[0], r1[0], r0[1], r1[1]}; OUT = *reinterpret_cast<bf16x8*>(&w); } while (0)
    PK4(p0, 0, pa0); PK4(p0, 8, pa1); PK4(p1, 0, pa2); PK4(p1, 8, pa3);
#undef PK4
}
template <int KB> __device__ __forceinline__ void qkt(f32x16& p0, f32x16& p1, const char* lds, const int (&ka)[4], const int (&ra)[4], const bf16x8* qr) {
    p0 = f32x16{}; p1 = f32x16{};
#pragma unroll
    for (int d0 = 0; d0 < 8; ++d0) { const char* a = lds + ka[d0 & 3] + (OFF_KN + KB * SHM_KN + (d0 >> 2) * 128);
        const bf16x8 b0 = *reinterpret_cast<const bf16x8*>(a), b1 = *reinterpret_cast<const bf16x8*>(a + 32 * 256);
        p0 = __builtin_amdgcn_mfma_f32_32x32x16_bf16(b0, qr[d0], p0, 0, 0, 0); p1 = __builtin_amdgcn_mfma_f32_32x32x16_bf16(b1, qr[d0], p1, 0, 0, 0);
        if ((d0 & 3) == 3) SBAR(); }
#pragma unroll
    for (int d0 = 0; d0 < 4; ++d0) { const char* a = lds + ra[d0] + (OFF_KR + KB * SHM_KR);
        const bf16x8 b0 = *reinterpret_cast<const bf16x8*>(a), b1 = *reinterpret_cast<const bf16x8*>(a + 32 * 128);
        p0 = __builtin_amdgcn_mfma_f32_32x32x16_bf16(b0, qr[8 + d0], p0, 0, 0, 0); p1 = __builtin_amdgcn_mfma_f32_32x32x16_bf16(b1, qr[8 + d0], p1, 0, 0, 0); }
}
template <int VB> __device__ __forceinline__ void pv_tile(f32x16* o, int vb0, bf16x8 pa0, bf16x8 pa1, bf16x8 pa2, bf16x8 pa3) {
#define TRRD(dst, off) asm volatile("ds_read_b64_tr_b16 %0, %1 offset:%2" : "=&v"(dst) : "v"(vb0), "i"(off) : "memory")
#define PV_D0(d0) do { s16x4 l0, l1, l2, l3, h0, h1, h2, h3; constexpr int b_ = OFF_V + v_rd_off(d0, 0, 0); \
        TRRD(l0, b_); TRRD(h0, b_ + 2048); TRRD(l1, b_ + 4096); TRRD(h1, b_ + 6144); TRRD(l2, b_ + 8192); TRRD(h2, b_ + 10240); TRRD(l3, b_ + 12288); TRRD(h3, b_ + 14336); \
        asm volatile("s_waitcnt lgkmcnt(0)" ::: "memory"); SBAR(); \
        o[d0] = __builtin_amdgcn_mfma_f32_32x32x16_bf16(pa0, (bf16x8){l0[0], l0[1], l0[2], l0[3], h0[0], h0[1], h0[2], h0[3]}, o[d0], 0, 0, 0); \
        o[d0] = __builtin_amdgcn_mfma_f32_32x32x16_bf16(pa1, (bf16x8){l1[0], l1[1], l1[2], l1[3], h1[0], h1[1], h1[2], h1[3]}, o[d0], 0, 0, 0); \
        o[d0] = __builtin_amdgcn_mfma_f32_32x32x16_bf16(pa2, (bf16x8){l2[0], l2[1], l2[2], l2[3], h2[0], h2[1], h2[2], h2[3]}, o[d0], 0, 0, 0); \
        o[d0] = __builtin_amdgcn_mfma_f32_32x32x16_bf16(pa3, (bf16x8){l3[0], l3[1], l3[2], l3[3], h3[0], h3[1], h3[2], h3[3]}, o[d0], 0, 0, 0); } while (0)
    PV_D0(0); PV_D0(1); PV_D0(2); PV_D0(3);
#undef PV_D0
#undef TRRD
}
__device__ __forceinline__ void attn_unit(int b, int h, int qb, const bf16_t* Qm, const bf16_t* KVm, const bf16_t* KRm, bf16_t* Om, char* lds) {
    const int tid = threadIdx.x, wid = __builtin_amdgcn_readfirstlane(tid >> 6), lane = tid & 63, r32 = lane & 31, hi = lane >> 5;
    const size_t rowbase = (size_t)b * SEQ; const int q0 = qb * 256;
    bf16x8 qr[12];
    { const bf16_t* Qw = Qm + (rowbase + q0 + wid * 32 + r32) * NQ + h * QKD + hi * 8;
#pragma unroll
      for (int d0 = 0; d0 < 12; ++d0) qr[d0] = *reinterpret_cast<const bf16x8*>(Qw + d0 * 16); }
    const int NT = (q0 + 256) / KVBLK;
    const int qlo = q0 + wid * 32, qm = qlo + r32 - 4 * hi;
    float* wsf = (float*)(lds + OFF_WS) + wid * 64; float* li_l = wsf; float* al_l = wsf + 32;
    float m_reg = -1e30f, l_reg = 0.f; f32x16 o[4] = {};
    const int vb0 = (int)(uintptr_t)lds + v_rd_base(lane), vb1 = vb0 + SHM_V;
    int ka[4], ra[4];
#pragma unroll
    for (int dd = 0; dd < 4; ++dd) { ka[dd] = KSWZ(r32, (dd * 16 + hi * 8) * 2); ra[dd] = KRSWZ(r32, (dd * 16 + hi * 8) * 2); }
    const char* Kb = (const char*)(KVm + rowbase * NKV + h * 128); const char* Rb = (const char*)(KRm + rowbase * 64);
    bf16x8 st_k0, st_k1, st_v0, st_v1, st_r;
#define SLOAD(t) do { int t_ = tid; asm volatile("" : "+v"(t_)); const unsigned sr_ = (unsigned)t_ >> 4, sc_ = ((unsigned)t_ & 15u) * 8u; \
        const char* kp_ = Kb + (size_t)(t) * (KVBLK * NKV * 2); const unsigned o_ = (sr_ * NKV + sc_) * 2u; \
        st_v0 = *reinterpret_cast<const bf16x8*>(kp_ + 3072 + o_); st_v1 = *reinterpret_cast<const bf16x8*>(kp_ + 3072 + 32 * NKV * 2 + o_); \
        st_k0 = *reinterpret_cast<const bf16x8*>(kp_ + o_); st_k1 = *reinterpret_cast<const bf16x8*>(kp_ + 32 * NKV * 2 + o_); \
        st_r = *reinterpret_cast<const bf16x8*>(Rb + (size_t)(t) * (KVBLK * 64 * 2) + (unsigned)t_ * 16u); } while (0)
#define SWRITE(bf) do { int t_ = tid; asm volatile("" : "+v"(t_)); const int sr_ = t_ >> 4, sc_ = (t_ & 15) * 8; \
        *(bf16x8*)(lds + OFF_V + (bf) * SHM_V + v_st(sr_, sc_)) = st_v0; *(bf16x8*)(lds + OFF_V + (bf) * SHM_V + v_st(32 + sr_, sc_)) = st_v1; \
        const int kws_ = KSWZ(sr_, sc_ * 2); *(bf16x8*)(lds + OFF_KN + (bf) * SHM_KN + kws_) = st_k0; *(bf16x8*)(lds + OFF_KN + (bf) * SHM_KN + kws_ + 32 * 256) = st_k1; \
        *(bf16x8*)(lds + OFF_KR + (bf) * SHM_KR + KRSWZ(t_ >> 3, (t_ & 7) * 16)) = st_r; } while (0)
#define VMW() asm volatile("s_waitcnt vmcnt(0)" ::: "memory")
#define RESC(a) do { if (__any((a) < 1.f)) { if (hi == 0) al_l[r32] = (a); asm volatile("s_waitcnt lgkmcnt(0)" ::: "memory"); \
        _Pragma("unroll") for (int d_ = 0; d_ < 4; ++d_) _Pragma("unroll") for (int r = 0; r < 16; ++r) o[d_][r] *= al_l[crow(r, hi)]; } } while (0)
#define STEP(t, KB, NB) do { f32x16 p0, p1; float alpha; bf16x8 pa0, pa1, pa2, pa3; const int kb_ = (t) * KVBLK; \
        SBAR(); qkt<KB>(p0, p1, lds, ka, ra, qr); \
        if (kb_ + KVBLK - 1 > qlo) mask_tile(p0, p1, qm - kb_); \
        softmax_tile(p0, p1, m_reg, l_reg, alpha, pa0, pa1, pa2, pa3); RESC(alpha); SBAR(); \
        pv_tile<KB>(o, (KB) ? vb1 : vb0, pa0, pa1, pa2, pa3); \
        if ((t) + 1 < NT) { VMW(); SWRITE(NB); SBAR(); if ((t) + 2 < NT) SLOAD((t) + 2); } \
        __syncthreads(); } while (0)
    SLOAD(0); VMW(); SWRITE(0); SBAR(); SLOAD(1);
    __syncthreads();
    for (int t = 0; t < NT; t += 2) { STEP(t, 0, 1); STEP(t + 1, 1, 0); }
    if (hi == 0) li_l[r32] = l_reg; asm volatile("s_waitcnt lgkmcnt(0)" ::: "memory");
    int hi_e = hi; asm volatile("" : "+v"(hi_e));
    bf16_t* Ow = Om + (rowbase + q0 + wid * 32) * D + DPOOL + h * 128 + (size_t)(4 * hi_e) * D + r32;
#pragma unroll
    for (int r = 0; r < 16; ++r) { const int orow = (r & 3) + 8 * (r >> 2); const float rl = __builtin_amdgcn_rcpf(li_l[orow + 4 * hi_e]);
#pragma unroll
        for (int d0 = 0; d0 < 4; ++d0) { const float v = o[d0][r] * rl; const float vn = __shfl_xor(v, 1);
            if ((r32 & 1) == 0) *(unsigned*)(Ow + orow * D + d0 * 32) = cvtpk(v, vn); } }
    __syncthreads();
#undef SLOAD
#undef SWRITE
#undef VMW
#undef RESC
#undef STEP
}
#undef KSWZ
#undef KRSWZ
#undef SBAR
}

struct Args {
    const float *x, *p; const int* positions; const float *mix_g, *w_in, *pool_w, *pool_scale, *q_g, *w_uq, *kv_g, *w_ukv, *w_o, *ffn_g, *peer_wq, *sub_keys, *peer_u, *peer_v, *ple_g, *ple_wg, *ple_wp, *final_g;
    float* out; unsigned char* ws; int ph_lo, ph_hi;
};

template <class Map> __device__ __forceinline__ void transpose_item(const float* W, int ldw, const float* kscale, bf16_t* WT, int ldt, LAS float* scr, int k0, int n0, int lane, Map map) {
    const int ns = map(n0 + (lane & 31));
#pragma unroll 8
    for (int i = 0; i < 32; ++i) { const int kk = 2 * i + (lane >> 5); float v = ns >= 0 ? W[(size_t)(k0 + kk) * ldw + ns] : 0.f; if (kscale) v *= kscale[k0 + kk]; scr[kk * 33 + (lane & 31)] = v; }
    LDS_WAIT(); asm volatile("" ::: "memory");
    const int c = lane & 7;
#pragma unroll
    for (int j = 0; j < 4; ++j) { const int n = (lane >> 3) + 8 * j; const LAS float* s = scr + (8 * c) * 33 + n;
        u32x4 o; o.x = cvt_pk_bf16(s[0 * 33], s[1 * 33]); o.y = cvt_pk_bf16(s[2 * 33], s[3 * 33]); o.z = cvt_pk_bf16(s[4 * 33], s[5 * 33]); o.w = cvt_pk_bf16(s[6 * 33], s[7 * 33]);
        *(u32x4*)(WT + (size_t)(n0 + n) * ldt + k0 + 8 * c) = o; }
    LDS_WAIT(); asm volatile("" ::: "memory");
}
__device__ __forceinline__ int rope_perm(int j) { return (j & 1) ? 32 + (j >> 1) : (j >> 1); }

__device__ __forceinline__ void p0_prologue(const Args& a, LAS unsigned char* lds, int vcu, int G, int tid, int lane, int wave) {
    unsigned char* ws = a.ws;
    const int gw = vcu * NWAVES + wave, NGW = G * NWAVES;
    const int gt = vcu * NTHR + tid, NGT = G * NTHR;
    { u64* st = (u64*)(ws + WS_CTL); for (int i = gt; i < 4 * T; i += NGT) st[i] = 0ull; }
    { bf16_t* XN = (bf16_t*)(ws + WS_AB);
      for (int r = gw; r < T; r += NGW) { const f32x4* xr = (const f32x4*)(a.x + (size_t)r * D) + lane; f32x4 v[8]; float s = 0.f;
#pragma unroll
          for (int j = 0; j < 8; ++j) { v[j] = xr[64 * j]; s += (v[j][0] * v[j][0] + v[j][1] * v[j][1]) + (v[j][2] * v[j][2] + v[j][3] * v[j][3]); }
          const float ri = rsqrtf(wave_sum(s) * (1.f / D) + EPS);
          u32x2* o = (u32x2*)(XN + (size_t)r * D) + lane;
#pragma unroll
          for (int j = 0; j < 8; ++j) { u32x2 w; w.x = cvt_pk_bf16(v[j][0] * ri, v[j][1] * ri); w.y = cvt_pk_bf16(v[j][2] * ri, v[j][3] * ri); o[64 * j] = w; } } }
    { u32x2* PB = (u32x2*)(ws + WS_PB); const f32x4* ps = (const f32x4*)a.p;
      for (int i = gt; i < T * DPLE / 4; i += NGT) { const f32x4 v = ps[i]; u32x2 w; w.x = cvt_pk_bf16(v[0], v[1]); w.y = cvt_pk_bf16(v[2], v[3]); PB[i] = w; } }
    { float* RP = (float*)(ws + WS_ROPE);
      for (int i = gt; i < T * 32; i += NGT) { const int r = i >> 5, f = i & 31; const float invf = exp2f(-(float)f * (13.287712379549449f / 32.f));
          const float ang = (float)a.positions[r] * invf; float sn, cs; sincosf(ang, &sn, &cs); RP[(size_t)r * 64 + f] = cs; RP[(size_t)r * 64 + 32 + f] = sn; } }
    { LAS float* scr = (LAS float*)(lds + wave * 16384);
      constexpr int I_IN = 32 * 56, I_UQ = 8 * 72, I_UKV = 8 * 96, I_O = 24 * 64, I_Q = 32 * 64, I_G = 32 * 64, I_P = 4 * 64;
      constexpr int NIT = I_IN + I_UQ + I_UKV + I_O + I_Q + I_G + I_P;
      for (int it = gw; it < NIT; it += NGW) { int r = it;
          if (r < I_IN) { transpose_item(a.w_in, DIN, a.mix_g, (bf16_t*)(ws + WS_WIN), D, scr, (r / 56) * 64, (r % 56) * 32, lane,
                [](int n) { return n < 1536 ? n : (n < 1600 ? 1536 + rope_perm(n - 1536) : -1); }); continue; } r -= I_IN;
          if (r < I_UQ) { transpose_item(a.w_uq, NQ, a.q_g, (bf16_t*)(ws + WS_WUQ), 512, scr, (r / 72) * 64, (r % 72) * 32, lane,
                [](int n) { const int h = n / QKD, c = n % QKD; return c < 128 ? n : h * QKD + 128 + rope_perm(c - 128); }); continue; } r -= I_UQ;
          if (r < I_UKV) { transpose_item(a.w_ukv, NKV, a.kv_g, (bf16_t*)(ws + WS_WUKV), 512, scr, (r / 96) * 64, (r % 96) * 32, lane,
                [](int n) { return n < 1536 ? (n >> 7) * 256 + (n & 127) : ((n - 1536) >> 7) * 256 + 128 + (n & 127); }); continue; } r -= I_UKV;
          if (r < I_O) { transpose_item(a.w_o, D, nullptr, (bf16_t*)(ws + WS_WO), D, scr, 512 + (r / 64) * 64, (r % 64) * 32, lane, [](int n) { return n; }); continue; } r -= I_O;
          if (r < I_Q) { transpose_item(a.peer_wq, D, a.ffn_g, (bf16_t*)(ws + WS_WQ), D, scr, (r / 64) * 64, (r % 64) * 32, lane, [](int n) { return n; }); continue; } r -= I_Q;
          if (r < I_G) { transpose_item(a.ple_wg, D, a.ple_g, (bf16_t*)(ws + WS_WG), D, scr, (r / 64) * 64, (r % 64) * 32, lane, [](int n) { return n; }); continue; } r -= I_G;
          transpose_item(a.ple_wp, D, nullptr, (bf16_t*)(ws + WS_WP), DPLE, scr, (r / 64) * 64, (r % 64) * 32, lane, [](int n) { return n; });
      } }
    { bf16_t* WO = (bf16_t*)(ws + WS_WO);
      for (int i = gt; i < DPOOL * D; i += NGT) { const int n = i & (D - 1), k = i >> 11, g = k >> 7; const float* pw = a.pool_w + (size_t)k * 128; float s = 0.f;
          for (int d = 0; d < 128; ++d) s += pw[d] * a.pool_scale[g * 128 + d] * a.w_o[(size_t)(g * 128 + d) * D + n];
          WO[(size_t)n * D + k] = (bf16_t)(cvt_pk_bf16(s, 0.f) & 0xffffu); } }
    { bf16_t* SK = (bf16_t*)(ws + WS_SK);
      for (int i = gt; i < PH * 256 * 256; i += NGT) { const int c = i & 255, r = (i >> 8) & 255, h = i >> 16, pp = r >> 7;
          const float v = ((c >> 7) == pp) ? a.sub_keys[((size_t)(h * 2 + pp) * 128 + (r & 127)) * 128 + (c & 127)] : 0.f; SK[i] = (bf16_t)(cvt_pk_bf16(v, 0.f) & 0xffffu); } }
    { const f32x4* us = (const f32x4*)a.peer_u; const f32x4* vs = (const f32x4*)a.peer_v; u32x2* UT = (u32x2*)(ws + WS_UT); u32x2* VT = (u32x2*)(ws + WS_VT);
      for (int i = gt; i < NEXP * D / 4; i += NGT) { const f32x4 u = us[i], v = vs[i]; u32x2 w; w.x = cvt_pk_bf16(u[0], u[1]); w.y = cvt_pk_bf16(u[2], u[3]); UT[i] = w;
          w.x = cvt_pk_bf16(v[0], v[1]); w.y = cvt_pk_bf16(v[2], v[3]); VT[i] = w; } }
}

typedef __bf16 bf16x2v __attribute__((ext_vector_type(2)));
__device__ __forceinline__ float dot2bf(unsigned a, unsigned b, float c) { return __builtin_amdgcn_fdot2_f32_bf16(__builtin_bit_cast(bf16x2v, a), __builtin_bit_cast(bf16x2v, b), c, false); }
__device__ __forceinline__ void p6_experts(const Args& a, int vcu, int G, int lane, int wave) {
    const int gw = vcu * NWAVES + wave, NGW = G * NWAVES; const char* ABc = (const char*)(a.ws + WS_AB); u64* st = (u64*)(a.ws + WS_CTL); float* rinv_ple = (float*)(st + 4 * T); const u64* ssq_ffn = st + 2 * T;
    const char* UT = (const char*)(a.ws + WS_UT); const char* VT = (const char*)(a.ws + WS_VT);
    const int* EID = (const int*)(a.ws + WS_EID); const float* GATE = (const float*)(a.ws + WS_GATE);
    const int b4 = (lane >> 4) & 1, b3 = (lane >> 3) & 1, b2 = (lane >> 2) & 1, b5 = lane >> 5;
    const unsigned lo32 = (unsigned)lane * 32u, lo16 = (unsigned)lane * 16u, lo4 = (unsigned)(lane >> 2) * 4u;
#pragma unroll 1
    for (int rr = gw; rr < T; rr += NGW) {
        const int r = __builtin_amdgcn_readfirstlane(rr);
        const char* hr = (const char*)(a.out + (size_t)r * D);
#if PEER_ON
        const float ri = rsqrtf(ssq_get(ssq_ffn + r) * (1.f / D) + EPS);
        unsigned xb[16];
#pragma unroll
        for (int c = 0; c < 4; ++c) { const f32x4 g0 = *(const f32x4*)((const char*)a.ffn_g + c * 2048 + lo32), g1 = *(const f32x4*)((const char*)a.ffn_g + c * 2048 + 16 + lo32);
            const f32x4 x0 = *(const f32x4*)(hr + c * 2048 + lo32) * ri * g0, x1 = *(const f32x4*)(hr + c * 2048 + 16 + lo32) * ri * g1;
            xb[4 * c] = cvt_pk_bf16(x0[0], x0[1]); xb[4 * c + 1] = cvt_pk_bf16(x0[2], x0[3]); xb[4 * c + 2] = cvt_pk_bf16(x1[0], x1[1]); xb[4 * c + 3] = cvt_pk_bf16(x1[2], x1[3]); }
        float ov[32];
#pragma unroll
        for (int i = 0; i < 32; ++i) ov[i] = 0.f;
#pragma unroll 1
        for (int hd = 0; hd < PH; ++hd) {
            const char* eb = (const char*)(EID + (size_t)r * 128 + hd * 16); const char* gb = (const char*)(GATE + (size_t)r * 128 + hd * 16);
            const int my_e = *(const int*)(eb + lo4); const float my_g = *(const float*)(gb + lo4);
            float my_h = 0.f;
#pragma unroll 1
            for (int kg = 0; kg < 4; ++kg) { u32x4 w[4][4];
#pragma unroll
                for (int j = 0; j < 4; ++j) { const int e = __builtin_amdgcn_readlane(my_e, 16 * kg + 4 * j); const char* up = UT + (size_t)e * (D * 2);
#pragma unroll
                    for (int c = 0; c < 4; ++c) w[j][c] = *(const u32x4*)(up + c * 1024 + lo16); }
                float pt[4];
#pragma unroll
                for (int j = 0; j < 4; ++j) { float s = 0.f;
#pragma unroll
                    for (int c = 0; c < 4; ++c) { s = dot2bf(xb[4 * c], w[j][c].x, s); s = dot2bf(xb[4 * c + 1], w[j][c].y, s); s = dot2bf(xb[4 * c + 2], w[j][c].z, s); s = dot2bf(xb[4 * c + 3], w[j][c].w, s); }
                    pt[j] = s; }
                float q0, q1, q;
                { const float k0 = b3 ? pt[2] : pt[0], s0 = b3 ? pt[0] : pt[2], k1 = b3 ? pt[3] : pt[1], s1 = b3 ? pt[1] : pt[3]; q0 = k0 + __shfl_xor(s0, 8); q1 = k1 + __shfl_xor(s1, 8); }
                { const float kk = b2 ? q1 : q0, ss = b2 ? q0 : q1; q = kk + __shfl_xor(ss, 4); }
                q += __shfl_xor(q, 1); q += __shfl_xor(q, 2); q += __shfl_xor(q, 16); q += __shfl_xor(q, 32);
                my_h = (kg == 2 * b5 + b4) ? q : my_h;
            }
            const float hh = my_h; const float tg = tanhf(0.7978845608028654f * (hh + 0.044715f * hh * hh * hh)); const float my_a = my_g * 0.5f * hh * (1.f + tg);
#pragma unroll 1
            for (int kg = 0; kg < 4; ++kg) { u32x4 w[4][4]; float ak[4];
#pragma unroll
                for (int j = 0; j < 4; ++j) { const int e = __builtin_amdgcn_readlane(my_e, 16 * kg + 4 * j); ak[j] = __uint_as_float(__builtin_amdgcn_readlane(__float_as_uint(my_a), 16 * kg + 4 * j));
                    const char* vp = VT + (size_t)e * (D * 2);
#pragma unroll
                    for (int c = 0; c < 4; ++c) w[j][c] = *(const u32x4*)(vp + c * 1024 + lo16); }
#pragma unroll
                for (int j = 0; j < 4; ++j)
#pragma unroll
                    for (int c = 0; c < 4; ++c) { const u32x4 ww = w[j][c]; const float aj = ak[j];
                        ov[8 * c + 0] += aj * bf_lo(ww.x); ov[8 * c + 1] += aj * bf_hi(ww.x); ov[8 * c + 2] += aj * bf_lo(ww.y); ov[8 * c + 3] += aj * bf_hi(ww.y);
                        ov[8 * c + 4] += aj * bf_lo(ww.z); ov[8 * c + 5] += aj * bf_hi(ww.z); ov[8 * c + 6] += aj * bf_lo(ww.w); ov[8 * c + 7] += aj * bf_hi(ww.w); }
            }
        }
        asm volatile("" ::: "memory");
        f32x4 hv[8];
#pragma unroll
        for (int c = 0; c < 4; ++c) { hv[2 * c] = *(const f32x4*)(hr + c * 2048 + lo32) + (f32x4){ov[8 * c], ov[8 * c + 1], ov[8 * c + 2], ov[8 * c + 3]};
            hv[2 * c + 1] = *(const f32x4*)(hr + c * 2048 + 16 + lo32) + (f32x4){ov[8 * c + 4], ov[8 * c + 5], ov[8 * c + 6], ov[8 * c + 7]}; }
#else
        f32x4 hv[8];
#pragma unroll
        for (int c = 0; c < 4; ++c) { hv[2 * c] = *(const f32x4*)(hr + c * 2048 + lo32); hv[2 * c + 1] = *(const f32x4*)(hr + c * 2048 + 16 + lo32); }
#endif
        float s = 0.f;
#pragma unroll
        for (int j = 0; j < 8; ++j) s += (hv[j][0] * hv[j][0] + hv[j][1] * hv[j][1]) + (hv[j][2] * hv[j][2] + hv[j][3] * hv[j][3]);
        const float rp = rsqrtf(wave_sum(s) * (1.f / D) + EPS); if (lane == 0) rinv_ple[r] = rp;
        char* hw = (char*)(a.out + (size_t)r * D); char* abw = (char*)ABc + (size_t)r * (D * 2);
#pragma unroll
        for (int c = 0; c < 4; ++c) { *(f32x4*)(hw + c * 2048 + lo32) = hv[2 * c]; *(f32x4*)(hw + c * 2048 + 16 + lo32) = hv[2 * c + 1];
            u32x4 w; w.x = cvt_pk_bf16(hv[2 * c][0], hv[2 * c][1]); w.y = cvt_pk_bf16(hv[2 * c][2], hv[2 * c][3]); w.z = cvt_pk_bf16(hv[2 * c + 1][0], hv[2 * c + 1][1]); w.w = cvt_pk_bf16(hv[2 * c + 1][2], hv[2 * c + 1][3]);
            *(u32x4*)(abw + c * 1024 + lo16) = w; }
    }
}
__device__ __forceinline__ void p8_final(const Args& a, int vcu, int G, int lane, int wave) {
    const int gw = vcu * NWAVES + wave, NGW = G * NWAVES; const u64* ssq = (const u64*)(a.ws + WS_CTL) + 3 * T;
    f32x4 gv[8];
#pragma unroll
    for (int j = 0; j < 8; ++j) gv[j] = ((const f32x4*)a.final_g)[64 * j + lane];
    for (int r = gw; r < T; r += NGW) { f32x4* hr = (f32x4*)(a.out + (size_t)r * D) + lane; const float ri = rsqrtf(ssq_get(ssq + r) * (1.f / D) + EPS);
#pragma unroll
        for (int j = 0; j < 8; ++j) { f32x4 v = hr[64 * j]; v = v * ri * gv[j]; hr[64 * j] = v; } }
}


__device__ __forceinline__ void p2_pool_kr(const Args& a, int vcu, int G, int lane, int wave) {
    const int gw = vcu * NWAVES + wave, NGW = G * NWAVES; const bf16_t* Z = (const bf16_t*)(a.ws + WS_Z); bf16_t* AM = (bf16_t*)(a.ws + WS_AMIX); bf16_t* KR = (bf16_t*)(a.ws + WS_KR);
    const float* RP = (const float*)(a.ws + WS_ROPE);
    const int w = 2 << (lane >> 4);
    for (int t = gw; t < T; t += NGW) { const int s = t & (SEQ - 1); const int cnt = (s + 1 < w) ? s + 1 : w;
        const bf16_t* zp = Z + (size_t)t * DINP + 8 * lane; const u32x4 z0 = *(const u32x4*)zp;
        float acc[8]; acc[0] = bf_lo(z0.x); acc[1] = bf_hi(z0.x); acc[2] = bf_lo(z0.y); acc[3] = bf_hi(z0.y); acc[4] = bf_lo(z0.z); acc[5] = bf_hi(z0.z); acc[6] = bf_lo(z0.w); acc[7] = bf_hi(z0.w);
        float x0[8];
#pragma unroll
        for (int e = 0; e < 8; ++e) x0[e] = acc[e];
#pragma unroll
        for (int j = 1; j < 16; ++j) { if (j < cnt) { const u32x4 zz = *(const u32x4*)(zp - (size_t)j * DINP);
            acc[0] += bf_lo(zz.x); acc[1] += bf_hi(zz.x); acc[2] += bf_lo(zz.y); acc[3] += bf_hi(zz.y); acc[4] += bf_lo(zz.z); acc[5] += bf_hi(zz.z); acc[6] += bf_lo(zz.w); acc[7] += bf_hi(zz.w); } }
        const float ic = 1.f / (float)cnt; u32x4 o;
        o.x = cvt_pk_bf16(acc[0] * ic - x0[0], acc[1] * ic - x0[1]); o.y = cvt_pk_bf16(acc[2] * ic - x0[2], acc[3] * ic - x0[3]);
        o.z = cvt_pk_bf16(acc[4] * ic - x0[4], acc[5] * ic - x0[5]); o.w = cvt_pk_bf16(acc[6] * ic - x0[6], acc[7] * ic - x0[7]);
        *(u32x4*)(AM + (size_t)t * D + 8 * lane) = o;
#if ATTN_ZERO
        { const u32x4 zz = {0u, 0u, 0u, 0u}; u32x4* ap = (u32x4*)(AM + (size_t)t * D + DPOOL) + lane; ap[0] = zz; ap[64] = zz; ap[128] = zz; }
#endif
        if (lane < 32) { const unsigned kw = *(const unsigned*)(Z + (size_t)t * DINP + 1536 + 2 * lane); const float x1 = bf_lo(kw), x2 = bf_hi(kw);
            const float cs = RP[(size_t)t * 64 + lane], sn = RP[(size_t)t * 64 + 32 + lane];
            *(unsigned*)(KR + (size_t)t * 64 + 2 * lane) = cvt_pk_bf16(x1 * cs - x2 * sn, x2 * cs + x1 * sn); }
    }
}

constexpr int N_PHASES = 10;
constexpr float C2 = 0.07216878364870322f * 1.4426950408889634f;
__global__ void __launch_bounds__(NTHR, 2) hymba_fwd(Args a) {
    __builtin_assume(__builtin_amdgcn_workitem_id_y() == 0); __builtin_assume(__builtin_amdgcn_workitem_id_z() == 0);
    extern __shared__ __attribute__((aligned(16))) unsigned char lds_raw[];
    LAS unsigned char* lds = (LAS unsigned char*)lds_raw;
    cg::grid_group grid = cg::this_grid();
    const int tid = threadIdx.x, lane = tid & 63, wave = __builtin_amdgcn_readfirstlane(tid >> 6);
    const int G = gridDim.x; const int bx = blockIdx.x; const int vcu = (G % 8 == 0) ? (bx % 8) * (G / 8) + bx / 8 : bx;
    unsigned char* ws = a.ws;
    u64* ctl = (u64*)(ws + WS_CTL); float* rinv_ple = (float*)(ctl + 4 * T);
    const int lo = a.ph_lo, hi = a.ph_hi;
#define IN(k) (lo <= (k) && (k) < hi)
#define SEAM(k) do { if (IN(k) && IN((k) + 1)) grid.sync(); } while (0)

    if (IN(0)) { p0_prologue(a, lds, vcu, G, tid, lane, wave); }
    SEAM(0);
    if (IN(1)) {
        pg8::Gemm g{(const bf16_t*)(ws + WS_AB), (const bf16_t*)(ws + WS_WIN), D, D, D, 0}; pg8::StaticOrder S; S.init(T / 256, DINP / 256, G, bx);
        pg8::EpiBf16<DINP, false, true, false> E{(bf16_t*)(ws + WS_Z), nullptr, 0.f, 1.f, ctl, ctl + T, nullptr};
        pg8::gemm_phase<pg8::EpiBf16<DINP, false, true, false>, pg8::StaticOrder, true, true>(lds, g, S, E);
    }
    SEAM(1);
    if (IN(2)) {
        p2_pool_kr(a, vcu, G, lane, wave);
        { pg8::Gemm g{(const bf16_t*)(ws + WS_Z) + 512, (const bf16_t*)(ws + WS_WUQ), DINP, 512, 512, 0}; pg8::StaticOrder S; S.init(T / 256, NQ / 256, G, bx);
          pg8::EpiBf16<NQ, true, false, true> E{(bf16_t*)(ws + WS_Q), ctl, 1.f / 512.f, C2, nullptr, nullptr, (const float*)(ws + WS_ROPE)};
          pg8::gemm_phase<pg8::EpiBf16<NQ, true, false, true>, pg8::StaticOrder, true, true>(lds, g, S, E); }
        { pg8::Gemm g{(const bf16_t*)(ws + WS_Z) + 1024, (const bf16_t*)(ws + WS_WUKV), DINP, 512, 512, 0}; pg8::StaticOrder S; S.init(T / 256, NKV / 256, G, bx);
          pg8::EpiBf16<NKV, true, false, false> E{(bf16_t*)(ws + WS_KV), ctl + T, 1.f / 512.f, 1.f, nullptr, nullptr, nullptr};
          pg8::gemm_phase<pg8::EpiBf16<NKV, true, false, false>, pg8::StaticOrder, true, true>(lds, g, S, E); }
    }
    SEAM(2);
    if (IN(3)) {
        const bf16_t* Qm = (const bf16_t*)(ws + WS_Q); const bf16_t* KVm = (const bf16_t*)(ws + WS_KV); const bf16_t* KRm = (const bf16_t*)(ws + WS_KR); bf16_t* Om = (bf16_t*)(ws + WS_AMIX);
        for (int L = vcu; L < NB * NH * 16; L += G) { const int bh = L >> 4, x = L & 15, b = bh / NH, h = bh % NH;
            att::attn_unit(b, h, 31 - x, Qm, KVm, KRm, Om, (char*)lds_raw);
            att::attn_unit(b, h, x, Qm, KVm, KRm, Om, (char*)lds_raw); }
    }
    SEAM(3);
    if (IN(4)) {
        pg8::Gemm g{(const bf16_t*)(ws + WS_AMIX), (const bf16_t*)(ws + WS_WO), D, D, D, 0}; pg8::StaticOrder S; S.init(T / 256, D / 256, G, bx);
        pg8::EpiResF32 E{a.x, a.out, (bf16_t*)(ws + WS_AB), ctl + 2 * T};
        pg8::gemm_phase<pg8::EpiResF32, pg8::StaticOrder, true, true>(lds, g, S, E);
    }
    SEAM(4);
    if (IN(5)) {
        pg8::Gemm g{(const bf16_t*)(ws + WS_AB), (const bf16_t*)(ws + WS_WQ), D, D, D, 0}; pg8::StaticOrder S; S.init(T / 256, D / 256, G, bx);
        pg8::EpiBf16<D, true, false, false> E{(bf16_t*)(ws + WS_Q), ctl + 2 * T, 1.f / D, 1.f, nullptr, nullptr, nullptr};
        pg8::gemm_phase<pg8::EpiBf16<D, true, false, false>, pg8::StaticOrder, true, true>(lds, g, S, E);
    }
    if (IN(5)) {
        pg8::Gemm g{(const bf16_t*)(ws + WS_PB), (const bf16_t*)(ws + WS_WP), DPLE, DPLE, DPLE, 0}; pg8::StaticOrder S; S.init(T / 256, D / 256, G, bx);
        pg8::EpiBf16<D, false, false, false> E{(bf16_t*)(ws + WS_KV), nullptr, 0.f, 1.f, nullptr, nullptr, nullptr};
        pg8::gemm_phase<pg8::EpiBf16<D, false, false, false>, pg8::StaticOrder, true, true>(lds, g, S, E);
    }
    SEAM(5);
    if (IN(6)) {
        pg8::Gemm g{(const bf16_t*)(ws + WS_Q), (const bf16_t*)(ws + WS_SK), D, 256, 256, 256};
        pg8::EpiTopK E{(int*)(ws + WS_EID), (float*)(ws + WS_GATE)};
        for (int L = bx; L < (T / 256) * PH; L += G) { pg8::SingleUnit S; S.u0.pm = L >> 3; S.u0.pn = L & 7;
            pg8::gemm_phase<pg8::EpiTopK, pg8::SingleUnit, false, true>(lds, g, S, E); }
    }
    SEAM(6);
    if (IN(7)) { p6_experts(a, vcu, G, lane, wave); }
    SEAM(7);
    if (IN(8)) {
        pg8::Gemm g{(const bf16_t*)(ws + WS_AB), (const bf16_t*)(ws + WS_WG), D, D, D, 0}; pg8::StaticOrder S; S.init(T / 256, D / 256, G, bx);
        pg8::EpiPle E{a.out, (const bf16_t*)(ws + WS_KV), rinv_ple, ctl + 3 * T};
        pg8::gemm_phase<pg8::EpiPle, pg8::StaticOrder, true, true>(lds, g, S, E);
    }
    SEAM(8);
    if (IN(9)) { p8_final(a, vcu, G, lane, wave); }
#undef IN
#undef SEAM
}

extern "C" void kernel_launch(void* const* d_in, const int* in_sizes, int n_in, void* d_out, int out_size, void* d_ws, size_t ws_size, hipStream_t stream) {
    static int grid = 0;
    if (grid == 0) {
        if (n_in != 21 || out_size != T * D || ws_size < WS_END) { fprintf(stderr, "kernel_launch: unexpected shapes (n_in %d, out %d, ws %zu)\n", n_in, out_size, ws_size); grid = -1; return; }
        int dev = 0, cus = 0, per_cu = 0;
        hipGetDevice(&dev); hipDeviceGetAttribute(&cus, hipDeviceAttributeMultiprocessorCount, dev);
        if (hipFuncSetAttribute((const void*)hymba_fwd, hipFuncAttributeMaxDynamicSharedMemorySize, LDS_BYTES) != hipSuccess) { fprintf(stderr, "kernel_launch: hipFuncSetAttribute failed\n"); grid = -1; return; }
        if (hipOccupancyMaxActiveBlocksPerMultiprocessor(&per_cu, (const void*)hymba_fwd, NTHR, LDS_BYTES) != hipSuccess || per_cu < 1) { fprintf(stderr, "kernel_launch: occupancy query says %d\n", per_cu); grid = -1; (void)hipGetLastError(); return; }
        grid = cus;
    }
    if (grid < 0) return;
    Args a{};
    a.x = (const float*)d_in[0]; a.p = (const float*)d_in[1]; a.positions = (const int*)d_in[2]; a.mix_g = (const float*)d_in[3]; a.w_in = (const float*)d_in[4];
    a.pool_w = (const float*)d_in[5]; a.pool_scale = (const float*)d_in[6]; a.q_g = (const float*)d_in[7]; a.w_uq = (const float*)d_in[8]; a.kv_g = (const float*)d_in[9];
    a.w_ukv = (const float*)d_in[10]; a.w_o = (const float*)d_in[11]; a.ffn_g = (const float*)d_in[12]; a.peer_wq = (const float*)d_in[13]; a.sub_keys = (const float*)d_in[14];
    a.peer_u = (const float*)d_in[15]; a.peer_v = (const float*)d_in[16]; a.ple_g = (const float*)d_in[17]; a.ple_wg = (const float*)d_in[18]; a.ple_wp = (const float*)d_in[19];
    a.final_g = (const float*)d_in[20];
    a.out = (float*)d_out; a.ws = (unsigned char*)d_ws; a.ph_lo = 0; a.ph_hi = N_PHASES;
    void* args[] = {&a};
    hipError_t e = hipLaunchCooperativeKernel((const void*)hymba_fwd, dim3(grid), dim3(NTHR), args, LDS_BYTES, stream);
    if (e != hipSuccess) fprintf(stderr, "kernel_launch: cooperative launch failed: %s (grid %d)\n", hipGetErrorString(e), grid);
}
```

```cpp
#include <hip/hip_runtime.h>
#include <hip/hip_cooperative_groups.h>
#include <cstdio>
#include <cstdint>
namespace cg = cooperative_groups;

#define LAS __attribute__((address_space(3)))
typedef unsigned short bf16_t;
typedef short bf16x8 __attribute__((ext_vector_type(8)));
typedef float f32x4 __attribute__((ext_vector_type(4)));
typedef float f32x2 __attribute__((ext_vector_type(2)));
typedef unsigned u32x4 __attribute__((ext_vector_type(4)));
typedef unsigned u32x2 __attribute__((ext_vector_type(2)));

constexpr int T = 32768, SEQ = 8192, NB = 4, D = 2048, DIN = 1600, DINP = 1792, DPOOL = 512, DPLE = 256;
constexpr int NH = 12, QKD = 192, NQ = NH * QKD  , NKV = NH * 256  , DATT = 1536;
constexpr int PH = 8, PK = 128, PTOP = 16, NEXP = 16384;
constexpr float EPS = 1e-6f;
constexpr int NWAVES = 8, NTHR = 512;

constexpr size_t MiB = 1u << 20;
constexpr size_t WS_CTL = 932 * MiB;
constexpr size_t WS_WIN = 1 * MiB;
constexpr size_t WS_WUQ = 8 * MiB;
constexpr size_t WS_WUKV = 11 * MiB;
constexpr size_t WS_WO = 14 * MiB;
constexpr size_t WS_WQ = 22 * MiB;
constexpr size_t WS_SK = 30 * MiB;
constexpr size_t WS_WG = 31 * MiB;
constexpr size_t WS_WP = 39 * MiB;
constexpr size_t WS_ROPE = 40 * MiB;
constexpr size_t WS_KR = 48 * MiB;
constexpr size_t WS_PB = 52 * MiB;
constexpr size_t WS_EID = 68 * MiB;
constexpr size_t WS_GATE = 84 * MiB;
constexpr size_t WS_UT = 100 * MiB;
constexpr size_t WS_VT = 164 * MiB;
constexpr size_t WS_AB = 228 * MiB;
constexpr size_t WS_Z = 356 * MiB;
constexpr size_t WS_Q = 468 * MiB;
constexpr size_t WS_KV = 612 * MiB;
constexpr size_t WS_AMIX = 804 * MiB;
constexpr size_t WS_END = 934 * MiB;

#define ATTN_ZERO 0
#define PEER_ON 1
constexpr int LDS_BYTES = 147456;

typedef __bf16 bf16x2_t __attribute__((ext_vector_type(2)));
__device__ __forceinline__ unsigned cvt_pk_bf16(float lo, float hi) { f32x2 v = {lo, hi}; bf16x2_t b = __builtin_convertvector(v, bf16x2_t); return __builtin_bit_cast(unsigned, b); }
__device__ __forceinline__ float bf_lo(unsigned w) { return __uint_as_float(w << 16); }
__device__ __forceinline__ float bf_hi(unsigned w) { return __uint_as_float(w & 0xffff0000u); }
__device__ __forceinline__ float wave_sum(float v) {
#pragma unroll
    for (int o = 1; o < 64; o <<= 1) v += __shfl_xor(v, o);
    return v;
}
#define LDS_WAIT() asm volatile("s_waitcnt lgkmcnt(0)" ::: "memory")
typedef unsigned long long u64;
__device__ __forceinline__ void ssq_add(u64* p, float ss) { atomicAdd(p, (u64)(ss * 1048576.f + 0.5f)); }
__device__ __forceinline__ float ssq_get(const u64* p) { return (float)(*p) * (1.f / 1048576.f); }

namespace pg8 {
constexpr int BM = 256, BK = 64, HALF = 128, HTB = HALF * BK * 2, STAGE_BYTES = 8 * HTB, NXCD = 8, WGM = 8;
__host__ __device__ __forceinline__ int lds_byte(int r, int c) { const int st = (r >> 4) * 2 + (c >> 5), rr = r & 15, cc = c & 31, ob = rr * 64 + cc * 2; return st * 1024 + (ob ^ (((ob >> 9) & 1) << 5)); }
__host__ __device__ __forceinline__ void stage_rc(int b, int& R, int& C) { const int st = b / 1024, sb = b % 1024, swz = sb ^ (((sb >> 9) & 1) << 5); R = (st >> 1) * 16 + swz / 64; C = (st & 1) * 32 + (swz % 64) / 2; }
__host__ __device__ __forceinline__ int perm32(int rho) { const int n = rho >> 4, i = rho & 15; return 8 * (i >> 2) + 4 * n + (i & 3); }

struct Unit { int pm, pn; };
struct Gemm { const bf16_t* A; const bf16_t* Bt; int lda, ldb, K, acol_pn; };

struct StaticOrder {
    int nM, nN, nwg, G, c;
    __device__ void init(int nM_, int nN_, int G_, int c_) { nM = nM_; nN = nN_; nwg = nM * nN; G = G_; c = c_; }
    __device__ bool next(int i, Unit& u) const {
        const long L = (long)i * G + c; if (L >= nwg) return false;
        int wgid = (int)L; { const int q = nwg / NXCD, r = nwg % NXCD, xcd = wgid % NXCD, off = wgid / NXCD; wgid = (xcd < r ? xcd * (q + 1) : r * (q + 1) + (xcd - r) * q) + off; }
        const int nig = WGM * nN, gid = wgid / nig, fm = gid * WGM, gsz = (nM - fm) < WGM ? (nM - fm) : WGM;
        u.pm = fm + ((wgid % nig) % gsz); u.pn = (wgid % nig) / gsz; return true;
    }
};
struct SingleUnit {
    Unit u0;
    __device__ bool next(int i, Unit& u) const { if (i > 0) return false; u = u0; return true; }
};

template <class Epi, class Sched, bool ALIGN_EPI, bool SP2>
__device__ __forceinline__ void gemm_phase(LAS unsigned char* lds, const Gemm g, const Sched& S, const Epi& E) {
    const int tid = threadIdx.x, wid = __builtin_amdgcn_readfirstlane(tid >> 6), lane = tid & 63, wr = wid >> 2, wc = wid & 3, fr = lane & 15, fq = lane >> 4;
    int K_ = g.K; asm volatile("" : "+s"(K_));
    const int K = K_, nt = K / BK;
    unsigned voffA[2], voffB[2];
#pragma unroll
    for (int i = 0; i < 2; ++i) { int R, C; stage_rc(tid * 16 + i * 8192, R, C); const int Rb = Epi::PERM ? ((R & ~31) + perm32(R & 31)) : R;
        voffA[i] = (unsigned)(R * g.lda + C) * 2u; voffB[i] = (unsigned)(Rb * g.ldb + C) * 2u; }
    const size_t kstep = (size_t)(BK * 2);
    const size_t hstepA = (size_t)HALF * g.lda * 2, hstepB = (size_t)HALF * g.ldb * 2;
    const size_t tstepA = 2 * hstepA, tstepB = 2 * hstepB;
    const unsigned ldsw = (unsigned)wid * 1024u;
    const int aoff = lds_byte(wr * 64 + fr, fq * 8), boff = lds_byte(wc * 32 + fr, fq * 8);
#define PG8_SA(b, h) (((b) * 2 + (h)) * HTB)
#define PG8_SB(b, h) ((4 + (b) * 2 + (h)) * HTB)
#define PG8_STAGE(bufoff, gbase, voff) do { _Pragma("unroll") for (int _i = 0; _i < 2; ++_i) \
        __builtin_amdgcn_global_load_lds((const unsigned*)((const char*)(gbase) + (voff)[_i]), (LAS unsigned*)(lds + (bufoff) + ldsw + _i * 8192), 16, 0, 0); } while (0)
#define PG8_LDA(dst, b, h) do { _Pragma("unroll") for (int m = 0; m < 4; ++m) _Pragma("unroll") for (int k = 0; k < 2; ++k) dst[m][k] = *(const LAS bf16x8*)(lds + PG8_SA(b, h) + aoff + m * 2048 + k * 1024); } while (0)
#define PG8_LDB(dst, b, h) do { _Pragma("unroll") for (int n = 0; n < 2; ++n) _Pragma("unroll") for (int k = 0; k < 2; ++k) dst[n][k] = *(const LAS bf16x8*)(lds + PG8_SB(b, h) + boff + n * 2048 + k * 1024); } while (0)
#define PG8_MMA(ai, bj, At, Bt) do { __builtin_amdgcn_s_setprio(1); _Pragma("unroll") for (int m = 0; m < 4; ++m) _Pragma("unroll") for (int n = 0; n < 2; ++n) _Pragma("unroll") for (int k = 0; k < 2; ++k) \
        acc[ai][bj][m][n] = __builtin_amdgcn_mfma_f32_16x16x32_bf16(Bt[n][k], At[m][k], acc[ai][bj][m][n], 0, 0, 0); __builtin_amdgcn_s_setprio(0); } while (0)
#define PG8_WAIT_V(n) asm volatile("s_waitcnt vmcnt(" #n ")" ::: "memory")
#define PG8_WAIT_L(n) asm volatile("s_waitcnt lgkmcnt(" #n ")" ::: "memory")
#define PG8_BAR __builtin_amdgcn_s_barrier()
#define PG8_SCHED __builtin_amdgcn_sched_barrier(0)
    Unit cur, nxt; int ui = 0;
    if (!S.next(0, cur)) return;
    f32x4 acc[2][2][4][2];
#pragma unroll
    for (int a = 0; a < 2; ++a)
#pragma unroll
        for (int b = 0; b < 2; ++b)
#pragma unroll
            for (int m = 0; m < 4; ++m)
#pragma unroll
                for (int n = 0; n < 2; ++n) acc[a][b][m][n] = (f32x4){0.f, 0.f, 0.f, 0.f};
    bf16x8 At[4][2], B0[2][2], B1[2][2];
    const char* cA = (const char*)g.A + (size_t)cur.pm * tstepA + (size_t)cur.pn * g.acol_pn * 2; const char* cB = (const char*)g.Bt + (size_t)cur.pn * tstepB;
    if constexpr (SP2) {
        PG8_STAGE(PG8_SB(0, 0), cB, voffB); PG8_STAGE(PG8_SB(0, 1), cB + hstepB, voffB); PG8_STAGE(PG8_SA(0, 0), cA, voffA); PG8_STAGE(PG8_SA(0, 1), cA + hstepA, voffA);
        if (wr == 1) PG8_BAR;
        PG8_WAIT_V(2); PG8_BAR;
        PG8_STAGE(PG8_SB(1, 0), cB + kstep, voffB); PG8_STAGE(PG8_SA(1, 0), cA + kstep, voffA); PG8_STAGE(PG8_SB(1, 1), cB + hstepB + kstep, voffB);
        PG8_WAIT_V(6); PG8_BAR;
    } else {
        PG8_STAGE(PG8_SB(0, 0), cB, voffB); PG8_STAGE(PG8_SA(0, 0), cA, voffA); PG8_STAGE(PG8_SB(0, 1), cB + hstepB, voffB); PG8_STAGE(PG8_SA(0, 1), cA + hstepA, voffA);
        if (wr == 1) PG8_BAR;
        PG8_WAIT_V(4); PG8_BAR;
        PG8_STAGE(PG8_SB(1, 0), cB + kstep, voffB); PG8_STAGE(PG8_SA(1, 0), cA + kstep, voffA); PG8_STAGE(PG8_SB(1, 1), cB + hstepB + kstep, voffB);
        PG8_WAIT_V(6); PG8_BAR;
    }
    for (;;) {
        const bool has_next = S.next(ui + 1, nxt);
        const char* nA = has_next ? (const char*)g.A + (size_t)nxt.pm * tstepA + (size_t)nxt.pn * g.acol_pn * 2 : cA; const char* nB = has_next ? (const char*)g.Bt + (size_t)nxt.pn * tstepB : cB;
        for (int t = 0; t < nt; t += 2) {
            const bool last = (t == nt - 2);
            const char* a1 = cA + (size_t)(t + 1) * kstep;
            const char* a2 = last ? nA : cA + (size_t)(t + 2) * kstep; const char* b2 = last ? nB : cB + (size_t)(t + 2) * kstep;
            const char* a3 = a2 + kstep; const char* b3 = b2 + kstep;
            if constexpr (SP2) {
            PG8_LDB(B0, 0, 0); PG8_LDB(B1, 0, 1); PG8_SCHED; PG8_LDA(At, 0, 0); PG8_STAGE(PG8_SA(1, 1), a1 + hstepA, voffA);
            PG8_WAIT_V(8); PG8_WAIT_L(0); PG8_BAR; PG8_MMA(0, 0, At, B0); PG8_MMA(0, 1, At, B1); PG8_BAR; PG8_SCHED;
            PG8_LDA(At, 0, 1); PG8_STAGE(PG8_SB(0, 0), b2, voffB); PG8_STAGE(PG8_SB(0, 1), b2 + hstepB, voffB); PG8_STAGE(PG8_SA(0, 0), a2, voffA);
            PG8_WAIT_V(8); PG8_WAIT_L(0); PG8_BAR; PG8_MMA(1, 0, At, B0); PG8_MMA(1, 1, At, B1); PG8_BAR; PG8_SCHED;
            PG8_LDB(B0, 1, 0); PG8_LDB(B1, 1, 1); PG8_SCHED; PG8_LDA(At, 1, 0); PG8_STAGE(PG8_SA(0, 1), a2 + hstepA, voffA);
            PG8_WAIT_V(8); PG8_WAIT_L(0); PG8_BAR; PG8_MMA(0, 0, At, B0); PG8_MMA(0, 1, At, B1); PG8_BAR; PG8_SCHED;
            PG8_LDA(At, 1, 1); PG8_STAGE(PG8_SB(1, 0), b3, voffB); PG8_STAGE(PG8_SB(1, 1), b3 + hstepB, voffB); PG8_STAGE(PG8_SA(1, 0), a3, voffA);
            PG8_WAIT_V(8); PG8_WAIT_L(0); PG8_BAR; PG8_MMA(1, 0, At, B0); PG8_MMA(1, 1, At, B1); PG8_BAR; PG8_SCHED;
            } else {
            PG8_LDB(B0, 0, 0); PG8_SCHED; PG8_LDA(At, 0, 0); PG8_STAGE(PG8_SA(1, 1), a1 + hstepA, voffA);
            PG8_WAIT_L(8); PG8_BAR; PG8_WAIT_L(0); PG8_MMA(0, 0, At, B0); PG8_BAR; PG8_SCHED;
            PG8_LDB(B1, 0, 1); PG8_STAGE(PG8_SB(0, 0), b2, voffB);
            PG8_BAR; PG8_WAIT_L(0); PG8_MMA(0, 1, At, B1); PG8_BAR;
            PG8_LDA(At, 0, 1); PG8_STAGE(PG8_SA(0, 0), a2, voffA);
            PG8_BAR; PG8_WAIT_L(0); PG8_MMA(1, 0, At, B0); PG8_BAR; PG8_SCHED;
            PG8_STAGE(PG8_SB(0, 1), b2 + hstepB, voffB);
            PG8_WAIT_V(6); PG8_BAR; PG8_MMA(1, 1, At, B1); PG8_BAR;
            PG8_LDB(B0, 1, 0); PG8_SCHED; PG8_LDA(At, 1, 0); PG8_STAGE(PG8_SA(0, 1), a2 + hstepA, voffA);
            PG8_WAIT_L(8); PG8_BAR; PG8_WAIT_L(0); PG8_MMA(0, 0, At, B0); PG8_BAR; PG8_SCHED;
            PG8_LDB(B1, 1, 1); PG8_STAGE(PG8_SB(1, 0), b3, voffB);
            PG8_BAR; PG8_WAIT_L(0); PG8_MMA(0, 1, At, B1); PG8_BAR;
            PG8_LDA(At, 1, 1); PG8_STAGE(PG8_SA(1, 0), a3, voffA);
            PG8_BAR; PG8_WAIT_L(0); PG8_MMA(1, 0, At, B0); PG8_BAR; PG8_SCHED;
            PG8_STAGE(PG8_SB(1, 1), b3 + hstepB, voffB);
            PG8_WAIT_V(6); PG8_BAR; PG8_MMA(1, 1, At, B1); PG8_BAR;
            }
        }
        if constexpr (ALIGN_EPI) { if (wr == 0) PG8_BAR; }
        if constexpr (!Epi::AFTER_DRAIN) { E(acc, cur, wr, wc, fr, fq); }
        if (!has_next) break;
#pragma unroll
        for (int a = 0; a < 2; ++a)
#pragma unroll
            for (int b = 0; b < 2; ++b)
#pragma unroll
                for (int m = 0; m < 4; ++m)
#pragma unroll
                    for (int n = 0; n < 2; ++n) acc[a][b][m][n] = (f32x4){0.f, 0.f, 0.f, 0.f};
        cur = nxt; cA = nA; cB = nB; ++ui;
        if constexpr (ALIGN_EPI) { if (wr == 1) PG8_BAR; }
    }
    PG8_WAIT_V(0);
    if constexpr (!ALIGN_EPI) { if (wr == 0) PG8_BAR; }
    PG8_BAR;
    if constexpr (Epi::AFTER_DRAIN) { E.fused(acc, cur, wr, wc, fr, fq, lds, wid, lane); }
#undef PG8_SA
#undef PG8_SB
#undef PG8_STAGE
#undef PG8_LDA
#undef PG8_LDB
#undef PG8_MMA
#undef PG8_WAIT_V
#undef PG8_WAIT_L
#undef PG8_BAR
#undef PG8_SCHED
}


template <int LDC, bool RS, bool SSQ, bool ROPE> struct EpiBf16 {
    static constexpr bool PERM = true, AFTER_DRAIN = false;
    bf16_t* O; const u64* ssq_in; float inv_n, mul; u64* ssq_a; u64* ssq_b; const float* rope;
    __device__ __forceinline__ void operator()(const f32x4 (&acc)[2][2][4][2], const Unit& u, int wr, int wc, int fr, int fq) const {
        const int row0 = u.pm * BM + wr * 64 + fr, col0 = u.pn * BM + wc * 32 + 8 * fq;
        const bool do_ssq = SSQ && u.pn >= 2 && u.pn < 6;
#pragma unroll
        for (int ai = 0; ai < 2; ++ai)
#pragma unroll
            for (int m = 0; m < 4; ++m) {
                const int row = row0 + ai * HALF + m * 16;
                float sc = mul; if constexpr (RS) sc *= rsqrtf(ssq_get(ssq_in + row) * inv_n + EPS);
                float ss = 0.f;
#pragma unroll
                for (int bj = 0; bj < 2; ++bj) {
                    f32x4 v0 = acc[ai][bj][m][0] * sc, v1 = acc[ai][bj][m][1] * sc; const int col = col0 + bj * HALF;
                    if constexpr (ROPE) { const int cw = col % QKD;
                        if (cw >= 128) { const int i0 = (cw - 128) >> 1; const f32x4 cs = *(const f32x4*)(rope + (size_t)row * 64 + i0), sn = *(const f32x4*)(rope + (size_t)row * 64 + 32 + i0);
                            f32x4 a, b;
                            a[0] = v0[0] * cs[0] - v0[1] * sn[0]; a[1] = v0[1] * cs[0] + v0[0] * sn[0]; a[2] = v0[2] * cs[1] - v0[3] * sn[1]; a[3] = v0[3] * cs[1] + v0[2] * sn[1];
                            b[0] = v1[0] * cs[2] - v1[1] * sn[2]; b[1] = v1[1] * cs[2] + v1[0] * sn[2]; b[2] = v1[2] * cs[3] - v1[3] * sn[3]; b[3] = v1[3] * cs[3] + v1[2] * sn[3];
                            v0 = a; v1 = b; } }
                    if constexpr (SSQ) ss += (v0[0] * v0[0] + v0[1] * v0[1]) + (v0[2] * v0[2] + v0[3] * v0[3]) + (v1[0] * v1[0] + v1[1] * v1[1]) + (v1[2] * v1[2] + v1[3] * v1[3]);
                    u32x4 w; w.x = cvt_pk_bf16(v0[0], v0[1]); w.y = cvt_pk_bf16(v0[2], v0[3]); w.z = cvt_pk_bf16(v1[0], v1[1]); w.w = cvt_pk_bf16(v1[2], v1[3]);
                    *(u32x4*)(O + (size_t)row * LDC + col) = w;
                }
                if constexpr (SSQ) { if (do_ssq) { ss += __shfl_xor(ss, 16); ss += __shfl_xor(ss, 32); if (fq == 0) ssq_add((u.pn < 4 ? ssq_a : ssq_b) + row, ss); } }
                asm volatile("" ::: "memory");
            }
    }
};

struct EpiResF32 {
    static constexpr bool PERM = false, AFTER_DRAIN = false;
    const float* resid; float* outF; bf16_t* outB; u64* ssq;
    __device__ __forceinline__ void operator()(const f32x4 (&acc)[2][2][4][2], const Unit& u, int wr, int wc, int fr, int fq) const {
        const int row0 = u.pm * BM + wr * 64 + fr, col0 = u.pn * BM + wc * 32 + 4 * fq;
#pragma unroll
        for (int ai = 0; ai < 2; ++ai)
#pragma unroll
            for (int m = 0; m < 4; ++m) {
                const int row = row0 + ai * HALF + m * 16; const size_t off = (size_t)row * D + col0; float ss = 0.f;
#pragma unroll
                for (int bj = 0; bj < 2; ++bj)
#pragma unroll
                    for (int n = 0; n < 2; ++n) { const size_t o = off + bj * HALF + n * 16; const f32x4 v = *(const f32x4*)(resid + o) + acc[ai][bj][m][n];
                        *(f32x4*)(outF + o) = v; u32x2 w; w.x = cvt_pk_bf16(v[0], v[1]); w.y = cvt_pk_bf16(v[2], v[3]); *(u32x2*)(outB + o) = w;
                        ss += (v[0] * v[0] + v[1] * v[1]) + (v[2] * v[2] + v[3] * v[3]); }
                ss += __shfl_xor(ss, 16); ss += __shfl_xor(ss, 32); if (fq == 0) ssq_add(ssq + row, ss);
                asm volatile("" ::: "memory");
            }
    }
};

struct EpiPle {
    static constexpr bool PERM = false, AFTER_DRAIN = false;
    float* hio; const bf16_t* proj; const float* rinv; u64* ssq;
    __device__ __forceinline__ void operator()(const f32x4 (&acc)[2][2][4][2], const Unit& u, int wr, int wc, int fr, int fq) const {
        const int row0 = u.pm * BM + wr * 64 + fr, col0 = u.pn * BM + wc * 32 + 4 * fq;
#pragma unroll
        for (int ai = 0; ai < 2; ++ai)
#pragma unroll
            for (int m = 0; m < 4; ++m) {
                const int row = row0 + ai * HALF + m * 16; const size_t off = (size_t)row * D + col0; float ss = 0.f; const float ri = rinv[row];
#pragma unroll
                for (int bj = 0; bj < 2; ++bj)
#pragma unroll
                    for (int n = 0; n < 2; ++n) { const size_t o = off + bj * HALF + n * 16; const f32x4 h = *(const f32x4*)(hio + o); const u32x2 pw = *(const u32x2*)(proj + o);
                        const f32x4 a = acc[ai][bj][m][n] * ri; f32x4 v;
                        v[0] = h[0] + bf_lo(pw.x) / (1.f + __expf(-a[0])); v[1] = h[1] + bf_hi(pw.x) / (1.f + __expf(-a[1]));
                        v[2] = h[2] + bf_lo(pw.y) / (1.f + __expf(-a[2])); v[3] = h[3] + bf_hi(pw.y) / (1.f + __expf(-a[3]));
                        *(f32x4*)(hio + o) = v; ss += (v[0] * v[0] + v[1] * v[1]) + (v[2] * v[2] + v[3] * v[3]); }
                ss += __shfl_xor(ss, 16); ss += __shfl_xor(ss, 32); if (fq == 0) ssq_add(ssq + row, ss);
                asm volatile("" ::: "memory");
            }
    }
};

__device__ __forceinline__ unsigned mono(float v) { const unsigned u = __float_as_uint(v); return (u & 0x80000000u) ? ~u : (u | 0x80000000u); }
__device__ __forceinline__ float unmono(unsigned k) { return (k & 0x80000000u) ? __uint_as_float(k ^ 0x80000000u) : __uint_as_float(~k); }
__device__ __forceinline__ void ins16(unsigned (&L)[16], unsigned x) {
#pragma unroll
    for (int i = 0; i < 16; ++i) { const unsigned hi = L[i] > x ? L[i] : x; x = L[i] > x ? x : L[i]; L[i] = hi; }
}
struct EpiTopK {
    static constexpr bool PERM = false, AFTER_DRAIN = true;
    int* eid; float* gate;
    __device__ __forceinline__ void fused(f32x4 (&acc)[2][2][4][2], const Unit& u, int wr, int wc, int fr, int fq, LAS unsigned char* lds, int wid, int lane) const {
        LAS float* SL = (LAS float*)lds;
        LAS unsigned char* TAB = lds + 512 * 272;
        const int tid = wid * 64 + lane, half = tid & 1, pp = (tid >> 1) & 1, rowl = tid >> 2;
#pragma unroll
        for (int ai = 0; ai < 2; ++ai) {
#pragma unroll
            for (int m = 0; m < 4; ++m)
#pragma unroll
                for (int bj = 0; bj < 2; ++bj)
#pragma unroll
                    for (int n = 0; n < 2; ++n) { const int r = 64 * wr + 16 * m + fr, c = 32 * wc + 16 * n + 4 * fq; const int list = r * 4 + bj * 2 + (c >> 6);
                        *(LAS f32x4*)(SL + list * 68 + (c & 63)) = acc[ai][bj][m][n]; }
            asm volatile("s_waitcnt lgkmcnt(0)" ::: "memory"); __builtin_amdgcn_s_barrier(); asm volatile("" ::: "memory");
            unsigned L[16];
#pragma unroll
            for (int i = 0; i < 16; ++i) L[i] = 0u;
            { const LAS float* mine = SL + tid * 68; const int ib = 127 - half * 64;
#pragma unroll 2
              for (int k4 = 0; k4 < 16; ++k4) { const f32x4 v = *(const LAS f32x4*)(mine + 4 * k4);
#pragma unroll
                  for (int e = 0; e < 4; ++e) ins16(L, (mono(v[e]) & ~127u) | (unsigned)(ib - 4 * k4 - e)); } }
            unsigned M[16];
#pragma unroll
            for (int i = 0; i < 16; ++i) { const unsigned o = (unsigned)__shfl_xor((int)L[15 - i], 1); M[i] = L[i] > o ? L[i] : o; }
#pragma unroll
            for (int st = 8; st >= 1; st >>= 1)
#pragma unroll
                for (int i = 0; i < 16; ++i) if (!(i & st)) { const unsigned hi = M[i] > M[i + st] ? M[i] : M[i + st], lo2 = M[i] > M[i + st] ? M[i + st] : M[i]; M[i] = hi; M[i + st] = lo2; }
            if (half == 0) {
#pragma unroll
                for (int i = 0; i < 16; ++i) TAB[(rowl * 2 + pp) * 16 + i] = (unsigned char)(127u - (M[i] & 127u)); }
            float va[16], vb[16];
#pragma unroll
            for (int i = 0; i < 16; ++i) { const unsigned o = (unsigned)__shfl_xor((int)M[i], 2); va[i] = unmono(M[i] & ~127u); vb[i] = unmono(o & ~127u); }
            unsigned C[16];
#pragma unroll
            for (int i = 0; i < 16; ++i) C[i] = 0u;
#pragma unroll
            for (int x = 0; x < 16; ++x)
#pragma unroll
                for (int y = 0; y < 16; ++y) if ((x + 1) * (y + 1) <= 16) ins16(C, (mono(va[x] + vb[y]) & ~255u) | (unsigned)(255 - (x * 16 + y)));
            asm volatile("s_waitcnt lgkmcnt(0)" ::: "memory");
            if ((tid & 3) == 0) {
                const int token = u.pm * BM + ai * HALF + rowl; const size_t ob = (size_t)token * 128 + u.pn * 16;
                const float vmax = unmono(C[0] & ~255u); float ex[16], sum = 0.f; int ee[16];
#pragma unroll
                for (int k = 0; k < 16; ++k) { ex[k] = __expf(unmono(C[k] & ~255u) - vmax); sum += ex[k]; const unsigned code = 255u - (C[k] & 255u);
                    ee[k] = (int)TAB[(rowl * 2 + 0) * 16 + (code >> 4)] * 128 + (int)TAB[(rowl * 2 + 1) * 16 + (code & 15u)]; }
                const float is = 1.f / sum;
#pragma unroll
                for (int k4 = 0; k4 < 4; ++k4) { *(f32x4*)(gate + ob + 4 * k4) = (f32x4){ex[4 * k4] * is, ex[4 * k4 + 1] * is, ex[4 * k4 + 2] * is, ex[4 * k4 + 3] * is};
                    *(u32x4*)(eid + ob + 4 * k4) = (u32x4){(unsigned)ee[4 * k4], (unsigned)ee[4 * k4 + 1], (unsigned)ee[4 * k4 + 2], (unsigned)ee[4 * k4 + 3]}; }
            }
            asm volatile("s_waitcnt lgkmcnt(0)" ::: "memory"); __builtin_amdgcn_s_barrier(); asm volatile("" ::: "memory");
        }
    }
};
}


namespace att {
typedef short s16x4 __attribute__((ext_vector_type(4)));
typedef float f32x16 __attribute__((ext_vector_type(16)));
constexpr int KVBLK = 64, SHM_V = 16384, SHM_KN = 16384, SHM_KR = 8192;
constexpr int OFF_KN = 0, OFF_KR = 2 * SHM_KN, OFF_V = OFF_KR + 2 * SHM_KR, OFF_WS = OFF_V + 2 * SHM_V, LDS_NEED = OFF_WS + NWAVES * 64 * 4;
#define KSWZ(row, colB) ((row) * 256 + ((colB) ^ (((row) & 7) << 4)))
#define KRSWZ(row, colB) ((row) * 128 + ((colB) ^ (((row) & 7) << 4)))
#define SBAR() __builtin_amdgcn_sched_barrier(0)
__device__ __forceinline__ int v_st(int k, int c) { const int kk = (k & ~0xC) | ((k & 4) << 1) | ((k & 8) >> 1); return ((kk >> 3) * 4 + (c >> 5)) * 512 + ((kk & 7) * 32 + (c & 31)) * 2; }
__device__ __forceinline__ int v_rd_base(int lane) { return ((lane & 3) << 3) | (((lane >> 2) & 3) << 6) | (((lane >> 4) & 1) << 5) | (((lane >> 5) & 1) << 8); }
constexpr int v_rd_off(int d0, int ks, int half) { return d0 * 512 + ks * 4096 + half * 2048; }
__device__ __forceinline__ int crow(int r, int hi) { return (r & 3) + 8 * (r >> 2) + 4 * hi; }
__device__ __forceinline__ unsigned cvtpk(float lo, float hi) { unsigned r; asm volatile("v_cvt_pk_bf16_f32 %0, %1, %2" : "=v"(r) : "v"(lo), "v"(hi)); return r; }
__device__ __forceinline__ void mask_tile(f32x16& p0, f32x16& p1, int dq) {
    const float NEG = -__builtin_inff();
#pragma unroll
    for (int r = 0; r < 16; ++r) { const int c = (r & 3) + 8 * (r >> 2); if (dq - c < 0) p0[r] = NEG; if (dq - c - 32 < 0) p1[r] = NEG; }
}
__device__ __forceinline__ void softmax_tile(f32x16& p0, f32x16& p1, float& m_reg, float& l_reg, float& alpha, bf16x8& pa0, bf16x8& pa1, bf16x8& pa2, bf16x8& pa3) {
    float pmax = p0[0];
#pragma unroll
    for (int r = 1; r < 16; ++r) pmax = fmaxf(pmax, p0[r]);
#pragma unroll
    for (int r = 0; r < 16; ++r) pmax = fmaxf(pmax, p1[r]);
    { auto rr = __builtin_amdgcn_permlane32_swap(__float_as_uint(pmax), __float_as_uint(pmax), false, false); pmax = fmaxf(__uint_as_float(rr[0]), __uint_as_float(rr[1])); }
    float mn;
    if (__builtin_expect(__all((pmax - m_reg) <= 8.f), 1)) { mn = m_reg; alpha = 1.f; }
    else { mn = fmaxf(m_reg, pmax); alpha = __builtin_amdgcn_exp2f(m_reg - mn); m_reg = mn; }
    float ps = 0.f;
#pragma unroll
    for (int r = 0; r < 16; ++r) { p0[r] = __builtin_amdgcn_exp2f(p0[r] - mn); ps += p0[r]; }
#pragma unroll
    for (int r = 0; r < 16; ++r) { p1[r] = __builtin_amdgcn_exp2f(p1[r] - mn); ps += p1[r]; }
    { auto rr = __builtin_amdgcn_permlane32_swap(__float_as_uint(ps), __float_as_uint(ps), false, false); ps = __uint_as_float(rr[0]) + __uint_as_float(rr[1]); }
    l_reg = l_reg * alpha + ps;
#define PK4(P, B_, OUT) do { unsigned a0 = cvtpk(P[B_+0], P[B_+1]), a1 = cvtpk(P[B_+2], P[B_+3]); unsigned b0 = cvtpk(P[B_+4], P[B_+5]), b1 = cvtpk(P[B_+6], P[B_+7]); \
        auto r0 = __builtin_amdgcn_permlane32_swap(a0, b0, false, false); auto r1 = __builtin_amdgcn_permlane32_swap(a1, b1, false, false); \
        u32x4 w = {r0[0], r1[0], r0[1], r1[1]}; OUT = *reinterpret_cast<bf16x8*>(&w); } while (0)
    PK4(p0, 0, pa0); PK4(p0, 8, pa1); PK4(p1, 0, pa2); PK4(p1, 8, pa3);
#undef PK4
}
template <int KB> __device__ __forceinline__ void qkt(f32x16& p0, f32x16& p1, const char* lds, const int (&ka)[4], const int (&ra)[4], const bf16x8* qr) {
    p0 = f32x16{}; p1 = f32x16{};
#pragma unroll
    for (int d0 = 0; d0 < 8; ++d0) { const char* a = lds + ka[d0 & 3] + (OFF_KN + KB * SHM_KN + (d0 >> 2) * 128);
        const bf16x8 b0 = *reinterpret_cast<const bf16x8*>(a), b1 = *reinterpret_cast<const bf16x8*>(a + 32 * 256);
        p0 = __builtin_amdgcn_mfma_f32_32x32x16_bf16(b0, qr[d0], p0, 0, 0, 0); p1 = __builtin_amdgcn_mfma_f32_32x32x16_bf16(b1, qr[d0], p1, 0, 0, 0);
        if ((d0 & 3) == 3) SBAR(); }
#pragma unroll
    for (int d0 = 0; d0 < 4; ++d0) { const char* a = lds + ra[d0] + (OFF_KR + KB * SHM_KR);
        const bf16x8 b0 = *reinterpret_cast<const bf16x8*>(a), b1 = *reinterpret_cast<const bf16x8*>(a + 32 * 128);
        p0 = __builtin_amdgcn_mfma_f32_32x32x16_bf16(b0, qr[8 + d0], p0, 0, 0, 0); p1 = __builtin_amdgcn_mfma_f32_32x32x16_bf16(b1, qr[8 + d0], p1, 0, 0, 0); }
}
template <int VB> __device__ __forceinline__ void pv_tile(f32x16* o, int vb0, bf16x8 pa0, bf16x8 pa1, bf16x8 pa2, bf16x8 pa3) {
#define TRRD(dst, off) asm volatile("ds_read_b64_tr_b16 %0, %1 offset:%2" : "=&v"(dst) : "v"(vb0), "i"(off) : "memory")
#define PV_D0(d0) do { s16x4 l0, l1, l2, l3, h0, h1, h2, h3; constexpr int b_ = OFF_V + v_rd_off(d0, 0, 0); \
        TRRD(l0, b_); TRRD(h0, b_ + 2048); TRRD(l1, b_ + 4096); TRRD(h1, b_ + 6144); TRRD(l2, b_ + 8192); TRRD(h2, b_ + 10240); TRRD(l3, b_ + 12288); TRRD(h3, b_ + 14336); \
        asm volatile("s_waitcnt lgkmcnt(0)" ::: "memory"); SBAR(); \
        o[d0] = __builtin_amdgcn_mfma_f32_32x32x16_bf16(pa0, (bf16x8){l0[0], l0[1], l0[2], l0[3], h0[0], h0[1], h0[2], h0[3]}, o[d0], 0, 0, 0); \
        o[d0] = __builtin_amdgcn_mfma_f32_32x32x16_bf16(pa1, (bf16x8){l1[0], l1[1], l1[2], l1[3], h1[0], h1[1], h1[2], h1[3]}, o[d0], 0, 0, 0); \
        o[d0] = __builtin_amdgcn_mfma_f32_32x32x16_bf16(pa2, (bf16x8){l2[0], l2[1], l2[2], l2[3], h2[0], h2[1], h2[2], h2[3]}, o[d0], 0, 0, 0); \
        o[d0] = __builtin_amdgcn_mfma_f32_32x32x16_bf16(pa3, (bf16x8){l3[0], l3[1], l3[2], l3[3], h3[0], h3[1], h3[2], h3[3]}, o[d0], 0, 0, 0); } while (0)
    PV_D0(0); PV_D0(1); PV_D0(2); PV_D0(3);
#undef PV_D0
#undef TRRD
}
__device__ __forceinline__ void attn_unit(int b, int h, int qb, const bf16_t* Qm, const bf16_t* KVm, const bf16_t* KRm, bf16_t* Om, char* lds) {
    const int tid = threadIdx.x, wid = __builtin_amdgcn_readfirstlane(tid >> 6), lane = tid & 63, r32 = lane & 31, hi = lane >> 5;
    const size_t rowbase = (size_t)b * SEQ; const int q0 = qb * 256;
    bf16x8 qr[12];
    { const bf16_t* Qw = Qm + (rowbase + q0 + wid * 32 + r32) * NQ + h * QKD + hi * 8;
#pragma unroll
      for (int d0 = 0; d0 < 12; ++d0) qr[d0] = *reinterpret_cast<const bf16x8*>(Qw + d0 * 16); }
    const int NT = (q0 + 256) / KVBLK;
    const int qlo = q0 + wid * 32, qm = qlo + r32 - 4 * hi;
    float* wsf = (float*)(lds + OFF_WS) + wid * 64; float* li_l = wsf; float* al_l = wsf + 32;
    float m_reg = -1e30f, l_reg = 0.f; f32x16 o[4] = {};
    const int vb0 = (int)(uintptr_t)lds + v_rd_base(lane), vb1 = vb0 + SHM_V;
    int ka[4], ra[4];
#pragma unroll
    for (int dd = 0; dd < 4; ++dd) { ka[dd] = KSWZ(r32, (dd * 16 + hi * 8) * 2); ra[dd] = KRSWZ(r32, (dd * 16 + hi * 8) * 2); }
    const char* Kb = (const char*)(KVm + rowbase * NKV + h * 128); const char* Rb = (const char*)(KRm + rowbase * 64);
    bf16x8 st_k0, st_k1, st_v0, st_v1, st_r;
#define SLOAD(t) do { int t_ = tid; asm volatile("" : "+v"(t_)); const unsigned sr_ = (unsigned)t_ >> 4, sc_ = ((unsigned)t_ & 15u) * 8u; \
        const char* kp_ = Kb + (size_t)(t) * (KVBLK * NKV * 2); const unsigned o_ = (sr_ * NKV + sc_) * 2u; \
        st_v0 = *reinterpret_cast<const bf16x8*>(kp_ + 3072 + o_); st_v1 = *reinterpret_cast<const bf16x8*>(kp_ + 3072 + 32 * NKV * 2 + o_); \
        st_k0 = *reinterpret_cast<const bf16x8*>(kp_ + o_); st_k1 = *reinterpret_cast<const bf16x8*>(kp_ + 32 * NKV * 2 + o_); \
        st_r = *reinterpret_cast<const bf16x8*>(Rb + (size_t)(t) * (KVBLK * 64 * 2) + (unsigned)t_ * 16u); } while (0)
#define SWRITE(bf) do { int t_ = tid; asm volatile("" : "+v"(t_)); const int sr_ = t_ >> 4, sc_ = (t_ & 15) * 8; \
        *(bf16x8*)(lds + OFF_V + (bf) * SHM_V + v_st(sr_, sc_)) = st_v0; *(bf16x8*)(lds + OFF_V + (bf) * SHM_V + v_st(32 + sr_, sc_)) = st_v1; \
        const int kws_ = KSWZ(sr_, sc_ * 2); *(bf16x8*)(lds + OFF_KN + (bf) * SHM_KN + kws_) = st_k0; *(bf16x8*)(lds + OFF_KN + (bf) * SHM_KN + kws_ + 32 * 256) = st_k1; \
        *(bf16x8*)(lds + OFF_KR + (bf) * SHM_KR + KRSWZ(t_ >> 3, (t_ & 7) * 16)) = st_r; } while (0)
#define VMW() asm volatile("s_waitcnt vmcnt(0)" ::: "memory")
#define RESC(a) do { if (__any((a) < 1.f)) { if (hi == 0) al_l[r32] = (a); asm volatile("s_waitcnt lgkmcnt(0)" ::: "memory"); \
        _Pragma("unroll") for (int d_ = 0; d_ < 4; ++d_) _Pragma("unroll") for (int r = 0; r < 16; ++r) o[d_][r] *= al_l[crow(r, hi)]; } } while (0)
#define STEP(t, KB, NB) do { f32x16 p0, p1; float alpha; bf16x8 pa0, pa1, pa2, pa3; const int kb_ = (t) * KVBLK; \
        SBAR(); qkt<KB>(p0, p1, lds, ka, ra, qr); \
        if (kb_ + KVBLK - 1 > qlo) mask_tile(p0, p1, qm - kb_); \
        softmax_tile(p0, p1, m_reg, l_reg, alpha, pa0, pa1, pa2, pa3); RESC(alpha); SBAR(); \
        pv_tile<KB>(o, (KB) ? vb1 : vb0, pa0, pa1, pa2, pa3); \
        if ((t) + 1 < NT) { VMW(); SWRITE(NB); SBAR(); if ((t) + 2 < NT) SLOAD((t) + 2); } \
        __syncthreads(); } while (0)
    SLOAD(0); VMW(); SWRITE(0); SBAR(); SLOAD(1);
    __syncthreads();
    for (int t = 0; t < NT; t += 2) { STEP(t, 0, 1); STEP(t + 1, 1, 0); }
    if (hi == 0) li_l[r32] = l_reg; asm volatile("s_waitcnt lgkmcnt(0)" ::: "memory");
    int hi_e = hi; asm volatile("" : "+v"(hi_e));
    bf16_t* Ow = Om + (rowbase + q0 + wid * 32) * D + DPOOL + h * 128 + (size_t)(4 * hi_e) * D + r32;
#pragma unroll
    for (int r = 0; r < 16; ++r) { const int orow = (r & 3) + 8 * (r >> 2); const float rl = __builtin_amdgcn_rcpf(li_l[orow + 4 * hi_e]);
#pragma unroll
        for (int d0 = 0; d0 < 4; ++d0) { const float v = o[d0][r] * rl; const float vn = __shfl_xor(v, 1);
            if ((r32 & 1) == 0) *(unsigned*)(Ow + orow * D + d0 * 32) = cvtpk(v, vn); } }
    __syncthreads();
#undef SLOAD
#undef SWRITE
#undef VMW
#undef RESC
#undef STEP
}
#undef KSWZ
#undef KRSWZ
#undef SBAR
}

struct Args {
    const float *x, *p; const int* positions; const float *mix_g, *w_in, *pool_w, *pool_scale, *q_g, *w_uq, *kv_g, *w_ukv, *w_o, *ffn_g, *peer_wq, *sub_keys, *peer_u, *peer_v, *ple_g, *ple_wg, *ple_wp, *final_g;
    float* out; unsigned char* ws; int ph_lo, ph_hi;
};

template <class Map> __device__ __forceinline__ void transpose_item(const float* W, int ldw, const float* kscale, bf16_t* WT, int ldt, LAS float* scr, int k0, int n0, int lane, Map map) {
    const int ns = map(n0 + (lane & 31));
#pragma unroll 8
    for (int i = 0; i < 32; ++i) { const int kk = 2 * i + (lane >> 5); float v = ns >= 0 ? W[(size_t)(k0 + kk) * ldw + ns] : 0.f; if (kscale) v *= kscale[k0 + kk]; scr[kk * 33 + (lane & 31)] = v; }
    LDS_WAIT(); asm volatile("" ::: "memory");
    const int c = lane & 7;
#pragma unroll
    for (int j = 0; j < 4; ++j) { const int n = (lane >> 3) + 8 * j; const LAS float* s = scr + (8 * c) * 33 + n;
        u32x4 o; o.x = cvt_pk_bf16(s[0 * 33], s[1 * 33]); o.y = cvt_pk_bf16(s[2 * 33], s[3 * 33]); o.z = cvt_pk_bf16(s[4 * 33], s[5 * 33]); o.w = cvt_pk_bf16(s[6 * 33], s[7 * 33]);
        *(u32x4*)(WT + (size_t)(n0 + n) * ldt + k0 + 8 * c) = o; }
    LDS_WAIT(); asm volatile("" ::: "memory");
}
__device__ __forceinline__ int rope_perm(int j) { return (j & 1) ? 32 + (j >> 1) : (j >> 1); }

__device__ __forceinline__ void p0_prologue(const Args& a, LAS unsigned char* lds, int vcu, int G, int tid, int lane, int wave) {
    unsigned char* ws = a.ws;
    const int gw = vcu * NWAVES + wave, NGW = G * NWAVES;
    const int gt = vcu * NTHR + tid, NGT = G * NTHR;
    { u64* st = (u64*)(ws + WS_CTL); for (int i = gt; i < 4 * T; i += NGT) st[i] = 0ull; }
    { bf16_t* XN = (bf16_t*)(ws + WS_AB);
      for (int r = gw; r < T; r += NGW) { const f32x4* xr = (const f32x4*)(a.x + (size_t)r * D) + lane; f32x4 v[8]; float s = 0.f;
#pragma unroll
          for (int j = 0; j < 8; ++j) { v[j] = xr[64 * j]; s += (v[j][0] * v[j][0] + v[j][1] * v[j][1]) + (v[j][2] * v[j][2] + v[j][3] * v[j][3]); }
          const float ri = rsqrtf(wave_sum(s) * (1.f / D) + EPS);
          u32x2* o = (u32x2*)(XN + (size_t)r * D) + lane;
#pragma unroll
          for (int j = 0; j < 8; ++j) { u32x2 w; w.x = cvt_pk_bf16(v[j][0] * ri, v[j][1] * ri); w.y = cvt_pk_bf16(v[j][2] * ri, v[j][3] * ri); o[64 * j] = w; } } }
    { u32x2* PB = (u32x2*)(ws + WS_PB); const f32x4* ps = (const f32x4*)a.p;
      for (int i = gt; i < T * DPLE / 4; i += NGT) { const f32x4 v = ps[i]; u32x2 w; w.x = cvt_pk_bf16(v[0], v[1]); w.y = cvt_pk_bf16(v[2], v[3]); PB[i] = w; } }
    { float* RP = (float*)(ws + WS_ROPE);
      for (int i = gt; i < T * 32; i += NGT) { const int r = i >> 5, f = i & 31; const float invf = exp2f(-(float)f * (13.287712379549449f / 32.f));
          const float ang = (float)a.positions[r] * invf; float sn, cs; sincosf(ang, &sn, &cs); RP[(size_t)r * 64 + f] = cs; RP[(size_t)r * 64 + 32 + f] = sn; } }
    { LAS float* scr = (LAS float*)(lds + wave * 16384);
      constexpr int I_IN = 32 * 56, I_UQ = 8 * 72, I_UKV = 8 * 96, I_O = 24 * 64, I_Q = 32 * 64, I_G = 32 * 64, I_P = 4 * 64;
      constexpr int NIT = I_IN + I_UQ + I_UKV + I_O + I_Q + I_G + I_P;
      for (int it = gw; it < NIT; it += NGW) { int r = it;
          if (r < I_IN) { transpose_item(a.w_in, DIN, a.mix_g, (bf16_t*)(ws + WS_WIN), D, scr, (r / 56) * 64, (r % 56) * 32, lane,
                [](int n) { return n < 1536 ? n : (n < 1600 ? 1536 + rope_perm(n - 1536) : -1); }); continue; } r -= I_IN;
          if (r < I_UQ) { transpose_item(a.w_uq, NQ, a.q_g, (bf16_t*)(ws + WS_WUQ), 512, scr, (r / 72) * 64, (r % 72) * 32, lane,
                [](int n) { const int h = n / QKD, c = n % QKD; return c < 128 ? n : h * QKD + 128 + rope_perm(c - 128); }); continue; } r -= I_UQ;
          if (r < I_UKV) { transpose_item(a.w_ukv, NKV, a.kv_g, (bf16_t*)(ws + WS_WUKV), 512, scr, (r / 96) * 64, (r % 96) * 32, lane,
                [](int n) { return n < 1536 ? (n >> 7) * 256 + (n & 127) : ((n - 1536) >> 7) * 256 + 128 + (n & 127); }); continue; } r -= I_UKV;
          if (r < I_O) { transpose_item(a.w_o, D, nullptr, (bf16_t*)(ws + WS_WO), D, scr, 512 + (r / 64) * 64, (r % 64) * 32, lane, [](int n) { return n; }); continue; } r -= I_O;
          if (r < I_Q) { transpose_item(a.peer_wq, D, a.ffn_g, (bf16_t*)(ws + WS_WQ), D, scr, (r / 64) * 64, (r % 64) * 32, lane, [](int n) { return n; }); continue; } r -= I_Q;
          if (r < I_G) { transpose_item(a.ple_wg, D, a.ple_g, (bf16_t*)(ws + WS_WG), D, scr, (r / 64) * 64, (r % 64) * 32, lane, [](int n) { return n; }); continue; } r -= I_G;
          transpose_item(a.ple_wp, D, nullptr, (bf16_t*)(ws + WS_WP), DPLE, scr, (r / 64) * 64, (r % 64) * 32, lane, [](int n) { return n; });
      } }
    { bf16_t* WO = (bf16_t*)(ws + WS_WO);
      for (int i = gt; i < DPOOL * D; i += NGT) { const int n = i & (D - 1), k = i >> 11, g = k >> 7; const float* pw = a.pool_w + (size_t)k * 128; float s = 0.f;
          for (int d = 0; d < 128; ++d) s += pw[d] * a.pool_scale[g * 128 + d] * a.w_o[(size_t)(g * 128 + d) * D + n];
          WO[(size_t)n * D + k] = (bf16_t)(cvt_pk_bf16(s, 0.f) & 0xffffu); } }
    { bf16_t* SK = (bf16_t*)(ws + WS_SK);
      for (int i = gt; i < PH * 256 * 256; i += NGT) { const int c = i & 255, r = (i >> 8) & 255, h = i >> 16, pp = r >> 7;
          const float v = ((c >> 7) == pp) ? a.sub_keys[((size_t)(h * 2 + pp) * 128 + (r & 127)) * 128 + (c & 127)] : 0.f; SK[i] = (bf16_t)(cvt_pk_bf16(v, 0.f) & 0xffffu); } }
    { const f32x4* us = (const f32x4*)a.peer_u; const f32x4* vs = (const f32x4*)a.peer_v; unsigned* UT = (unsigned*)(ws + WS_UT); unsigned* VT = (unsigned*)(ws + WS_VT);
      for (int i = gt; i < NEXP * D / 4; i += NGT) { const f32x4 u = us[i] * 1024.f, v = vs[i] * 32.f;
          int w = __builtin_amdgcn_cvt_pk_fp8_f32(u[0], u[1], 0, false); w = __builtin_amdgcn_cvt_pk_fp8_f32(u[2], u[3], w, true); UT[i] = (unsigned)w;
          w = __builtin_amdgcn_cvt_pk_fp8_f32(v[0], v[1], 0, false); w = __builtin_amdgcn_cvt_pk_fp8_f32(v[2], v[3], w, true); VT[i] = (unsigned)w; } }
}

__device__ __forceinline__ void p6_experts(const Args& a, int vcu, int G, int lane, int wave) {
    const int gw = vcu * NWAVES + wave, NGW = G * NWAVES; char* ABc = (char*)(a.ws + WS_AB); u64* st = (u64*)(a.ws + WS_CTL); float* rinv_ple = (float*)(st + 4 * T); const u64* ssq_ffn = st + 2 * T;
    const char* UT = (const char*)(a.ws + WS_UT); const char* VT = (const char*)(a.ws + WS_VT);
    const int* EID = (const int*)(a.ws + WS_EID); const float* GATE = (const float*)(a.ws + WS_GATE);
    const int b4 = (lane >> 4) & 1, b3 = (lane >> 3) & 1, b2 = (lane >> 2) & 1, b5 = lane >> 5;
    const unsigned lo64 = (unsigned)lane * 64u, lo32 = (unsigned)lane * 32u, lo16 = (unsigned)lane * 16u, lo4 = (unsigned)(lane >> 2) * 4u;
#pragma unroll 1
    for (int rr = gw; rr < T; rr += NGW) {
        const int r = __builtin_amdgcn_readfirstlane(rr);
        const char* hr = (const char*)(a.out + (size_t)r * D);
#if PEER_ON
        const float ri = rsqrtf(ssq_get(ssq_ffn + r) * (1.f / D) + EPS);
        f32x2 xn[16];
#pragma unroll
        for (int c = 0; c < 2; ++c)
#pragma unroll
            for (int q = 0; q < 4; ++q) { const f32x4 hv = *(const f32x4*)(hr + c * 4096 + q * 16 + lo64), g = *(const f32x4*)((const char*)a.ffn_g + c * 4096 + q * 16 + lo64);
                const f32x4 x = hv * ri * g; xn[8 * c + 2 * q] = (f32x2){x[0], x[1]}; xn[8 * c + 2 * q + 1] = (f32x2){x[2], x[3]}; }
        f32x2 ov[16];
#pragma unroll
        for (int i = 0; i < 16; ++i) ov[i] = (f32x2){0.f, 0.f};
#pragma unroll 1
        for (int hd = 0; hd < PH; ++hd) {
            const char* eb = (const char*)(EID + (size_t)r * 128 + hd * 16); const char* gb = (const char*)(GATE + (size_t)r * 128 + hd * 16);
            const int my_e = *(const int*)(eb + lo4); const float my_g = *(const float*)(gb + lo4);
            float my_h = 0.f;
#pragma unroll 1
            for (int kg = 0; kg < 2; ++kg) { u32x4 w[8][2];
#pragma unroll
                for (int j = 0; j < 8; ++j) { const int e = __builtin_amdgcn_readlane(my_e, 32 * kg + 4 * j); const char* up = UT + (size_t)e * D;
#pragma unroll
                    for (int c = 0; c < 2; ++c) w[j][c] = *(const u32x4*)(up + c * 1024 + lo16); }
                float pt[8];
#pragma unroll
                for (int j = 0; j < 8; ++j) { f32x2 s2 = {0.f, 0.f};
#pragma unroll
                    for (int c = 0; c < 2; ++c)
#pragma unroll
                        for (int q = 0; q < 4; ++q) { const int ww = (int)w[j][c][q];
                            s2 += __builtin_amdgcn_cvt_pk_f32_fp8(ww, false) * xn[8 * c + 2 * q]; s2 += __builtin_amdgcn_cvt_pk_f32_fp8(ww, true) * xn[8 * c + 2 * q + 1]; }
                    pt[j] = s2[0] + s2[1]; }
                float q4[4], q2[2], q;
#pragma unroll
                for (int i = 0; i < 4; ++i) { const float keep = b4 ? pt[i + 4] : pt[i], send = b4 ? pt[i] : pt[i + 4]; q4[i] = keep + __shfl_xor(send, 16); }
#pragma unroll
                for (int i = 0; i < 2; ++i) { const float keep = b3 ? q4[i + 2] : q4[i], send = b3 ? q4[i] : q4[i + 2]; q2[i] = keep + __shfl_xor(send, 8); }
                { const float keep = b2 ? q2[1] : q2[0], send = b2 ? q2[0] : q2[1]; q = keep + __shfl_xor(send, 4); }
                q += __shfl_xor(q, 1); q += __shfl_xor(q, 2); q += __shfl_xor(q, 32);
                my_h = (kg == b5) ? q : my_h;
            }
            const float hh = my_h * (1.f / 1024.f); const float tg = tanhf(0.7978845608028654f * (hh + 0.044715f * hh * hh * hh)); const float my_a = my_g * 0.5f * hh * (1.f + tg) * (1.f / 32.f);
#pragma unroll 1
            for (int kg = 0; kg < 2; ++kg) { u32x4 w[8][2]; float ak[8];
#pragma unroll
                for (int j = 0; j < 8; ++j) { const int e = __builtin_amdgcn_readlane(my_e, 32 * kg + 4 * j); ak[j] = __uint_as_float(__builtin_amdgcn_readlane(__float_as_uint(my_a), 32 * kg + 4 * j));
                    const char* vp = VT + (size_t)e * D;
#pragma unroll
                    for (int c = 0; c < 2; ++c) w[j][c] = *(const u32x4*)(vp + c * 1024 + lo16); }
#pragma unroll
                for (int j = 0; j < 8; ++j) { const f32x2 a2 = {ak[j], ak[j]};
#pragma unroll
                    for (int c = 0; c < 2; ++c)
#pragma unroll
                        for (int q = 0; q < 4; ++q) { const int ww = (int)w[j][c][q];
                            ov[8 * c + 2 * q] += a2 * __builtin_amdgcn_cvt_pk_f32_fp8(ww, false); ov[8 * c + 2 * q + 1] += a2 * __builtin_amdgcn_cvt_pk_f32_fp8(ww, true); } }
            }
        }
        asm volatile("" ::: "memory");
        f32x4 hv[8];
#pragma unroll
        for (int c = 0; c < 2; ++c)
#pragma unroll
            for (int q = 0; q < 4; ++q) hv[4 * c + q] = *(const f32x4*)(hr + c * 4096 + q * 16 + lo64) + (f32x4){ov[8 * c + 2 * q][0], ov[8 * c + 2 * q][1], ov[8 * c + 2 * q + 1][0], ov[8 * c + 2 * q + 1][1]};
#else
        f32x4 hv[8];
#pragma unroll
        for (int c = 0; c < 2; ++c)
#pragma unroll
            for (int q = 0; q < 4; ++q) hv[4 * c + q] = *(const f32x4*)(hr + c * 4096 + q * 16 + lo64);
#endif
        float s = 0.f;
#pragma unroll
        for (int j = 0; j < 8; ++j) s += (hv[j][0] * hv[j][0] + hv[j][1] * hv[j][1]) + (hv[j][2] * hv[j][2] + hv[j][3] * hv[j][3]);
        const float rp = rsqrtf(wave_sum(s) * (1.f / D) + EPS); if (lane == 0) rinv_ple[r] = rp;
        char* hw = (char*)(a.out + (size_t)r * D); char* abw = ABc + (size_t)r * (D * 2);
#pragma unroll
        for (int c = 0; c < 2; ++c) {
#pragma unroll
            for (int q = 0; q < 4; ++q) *(f32x4*)(hw + c * 4096 + q * 16 + lo64) = hv[4 * c + q];
#pragma unroll
            for (int q = 0; q < 2; ++q) { u32x4 wv; wv.x = cvt_pk_bf16(hv[4 * c + 2 * q][0], hv[4 * c + 2 * q][1]); wv.y = cvt_pk_bf16(hv[4 * c + 2 * q][2], hv[4 * c + 2 * q][3]);
                wv.z = cvt_pk_bf16(hv[4 * c + 2 * q + 1][0], hv[4 * c + 2 * q + 1][1]); wv.w = cvt_pk_bf16(hv[4 * c + 2 * q + 1][2], hv[4 * c + 2 * q + 1][3]);
                *(u32x4*)(abw + c * 2048 + q * 16 + lo32) = wv; } }
    }
}
__device__ __forceinline__ void p8_final(const Args& a, int vcu, int G, int lane, int wave) {
    const int gw = vcu * NWAVES + wave, NGW = G * NWAVES; const u64* ssq = (const u64*)(a.ws + WS_CTL) + 3 * T;
    f32x4 gv[8];
#pragma unroll
    for (int j = 0; j < 8; ++j) gv[j] = ((const f32x4*)a.final_g)[64 * j + lane];
    for (int r = gw; r < T; r += NGW) { f32x4* hr = (f32x4*)(a.out + (size_t)r * D) + lane; const float ri = rsqrtf(ssq_get(ssq + r) * (1.f / D) + EPS);
#pragma unroll
        for (int j = 0; j < 8; ++j) { f32x4 v = hr[64 * j]; v = v * ri * gv[j]; hr[64 * j] = v; } }
}


__device__ __forceinline__ void p2_pool_kr(const Args& a, int vcu, int G, int lane, int wave) {
    const int gw = vcu * NWAVES + wave, NGW = G * NWAVES; const bf16_t* Z = (const bf16_t*)(a.ws + WS_Z); bf16_t* AM = (bf16_t*)(a.ws + WS_AMIX); bf16_t* KR = (bf16_t*)(a.ws + WS_KR);
    const float* RP = (const float*)(a.ws + WS_ROPE);
    const int w = 2 << (lane >> 4);
    for (int t = gw; t < T; t += NGW) { const int s = t & (SEQ - 1); const int cnt = (s + 1 < w) ? s + 1 : w;
        const bf16_t* zp = Z + (size_t)t * DINP + 8 * lane; const u32x4 z0 = *(const u32x4*)zp;
        float acc[8]; acc[0] = bf_lo(z0.x); acc[1] = bf_hi(z0.x); acc[2] = bf_lo(z0.y); acc[3] = bf_hi(z0.y); acc[4] = bf_lo(z0.z); acc[5] = bf_hi(z0.z); acc[6] = bf_lo(z0.w); acc[7] = bf_hi(z0.w);
        float x0[8];
#pragma unroll
        for (int e = 0; e < 8; ++e) x0[e] = acc[e];
#pragma unroll
        for (int j = 1; j < 16; ++j) { if (j < cnt) { const u32x4 zz = *(const u32x4*)(zp - (size_t)j * DINP);
            acc[0] += bf_lo(zz.x); acc[1] += bf_hi(zz.x); acc[2] += bf_lo(zz.y); acc[3] += bf_hi(zz.y); acc[4] += bf_lo(zz.z); acc[5] += bf_hi(zz.z); acc[6] += bf_lo(zz.w); acc[7] += bf_hi(zz.w); } }
        const float ic = 1.f / (float)cnt; u32x4 o;
        o.x = cvt_pk_bf16(acc[0] * ic - x0[0], acc[1] * ic - x0[1]); o.y = cvt_pk_bf16(acc[2] * ic - x0[2], acc[3] * ic - x0[3]);
        o.z = cvt_pk_bf16(acc[4] * ic - x0[4], acc[5] * ic - x0[5]); o.w = cvt_pk_bf16(acc[6] * ic - x0[6], acc[7] * ic - x0[7]);
        *(u32x4*)(AM + (size_t)t * D + 8 * lane) = o;
#if ATTN_ZERO
        { const u32x4 zz = {0u, 0u, 0u, 0u}; u32x4* ap = (u32x4*)(AM + (size_t)t * D + DPOOL) + lane; ap[0] = zz; ap[64] = zz; ap[128] = zz; }
#endif
        if (lane < 32) { const unsigned kw = *(const unsigned*)(Z + (size_t)t * DINP + 1536 + 2 * lane); const float x1 = bf_lo(kw), x2 = bf_hi(kw);
            const float cs = RP[(size_t)t * 64 + lane], sn = RP[(size_t)t * 64 + 32 + lane];
            *(unsigned*)(KR + (size_t)t * 64 + 2 * lane) = cvt_pk_bf16(x1 * cs - x2 * sn, x2 * cs + x1 * sn); }
    }
}

constexpr int N_PHASES = 10;
constexpr float C2 = 0.07216878364870322f * 1.4426950408889634f;
__global__ void __launch_bounds__(NTHR, 2) hymba_fwd(Args a) {
    __builtin_assume(__builtin_amdgcn_workitem_id_y() == 0); __builtin_assume(__builtin_amdgcn_workitem_id_z() == 0);
    extern __shared__ __attribute__((aligned(16))) unsigned char lds_raw[];
    LAS unsigned char* lds = (LAS unsigned char*)lds_raw;
    cg::grid_group grid = cg::this_grid();
    const int tid = threadIdx.x, lane = tid & 63, wave = __builtin_amdgcn_readfirstlane(tid >> 6);
    const int G = gridDim.x; const int bx = blockIdx.x; const int vcu = (G % 8 == 0) ? (bx % 8) * (G / 8) + bx / 8 : bx;
    unsigned char* ws = a.ws;
    u64* ctl = (u64*)(ws + WS_CTL); float* rinv_ple = (float*)(ctl + 4 * T);
    const int lo = a.ph_lo, hi = a.ph_hi;
#define IN(k) (lo <= (k) && (k) < hi)
#define SEAM(k) do { if (IN(k) && IN((k) + 1)) grid.sync(); } while (0)

    if (IN(0)) { p0_prologue(a, lds, vcu, G, tid, lane, wave); }
    SEAM(0);
    if (IN(1)) {
        pg8::Gemm g{(const bf16_t*)(ws + WS_AB), (const bf16_t*)(ws + WS_WIN), D, D, D, 0}; pg8::StaticOrder S; S.init(T / 256, DINP / 256, G, bx);
        pg8::EpiBf16<DINP, false, true, false> E{(bf16_t*)(ws + WS_Z), nullptr, 0.f, 1.f, ctl, ctl + T, nullptr};
        pg8::gemm_phase<pg8::EpiBf16<DINP, false, true, false>, pg8::StaticOrder, true, true>(lds, g, S, E);
    }
    SEAM(1);
    if (IN(2)) {
        p2_pool_kr(a, vcu, G, lane, wave);
        { pg8::Gemm g{(const bf16_t*)(ws + WS_Z) + 512, (const bf16_t*)(ws + WS_WUQ), DINP, 512, 512, 0}; pg8::StaticOrder S; S.init(T / 256, NQ / 256, G, bx);
          pg8::EpiBf16<NQ, true, false, true> E{(bf16_t*)(ws + WS_Q), ctl, 1.f / 512.f, C2, nullptr, nullptr, (const float*)(ws + WS_ROPE)};
          pg8::gemm_phase<pg8::EpiBf16<NQ, true, false, true>, pg8::StaticOrder, true, true>(lds, g, S, E); }
        { pg8::Gemm g{(const bf16_t*)(ws + WS_Z) + 1024, (const bf16_t*)(ws + WS_WUKV), DINP, 512, 512, 0}; pg8::StaticOrder S; S.init(T / 256, NKV / 256, G, bx);
          pg8::EpiBf16<NKV, true, false, false> E{(bf16_t*)(ws + WS_KV), ctl + T, 1.f / 512.f, 1.f, nullptr, nullptr, nullptr};
          pg8::gemm_phase<pg8::EpiBf16<NKV, true, false, false>, pg8::StaticOrder, true, true>(lds, g, S, E); }
    }
    SEAM(2);
    if (IN(3)) {
        const bf16_t* Qm = (const bf16_t*)(ws + WS_Q); const bf16_t* KVm = (const bf16_t*)(ws + WS_KV); const bf16_t* KRm = (const bf16_t*)(ws + WS_KR); bf16_t* Om = (bf16_t*)(ws + WS_AMIX);
        for (int L = vcu; L < NB * NH * 16; L += G) { const int bh = L >> 4, x = L & 15, b = bh / NH, h = bh % NH;
            att::attn_unit(b, h, 31 - x, Qm, KVm, KRm, Om, (char*)lds_raw);
            att::attn_unit(b, h, x, Qm, KVm, KRm, Om, (char*)lds_raw); }
    }
    SEAM(3);
    if (IN(4)) {
        pg8::Gemm g{(const bf16_t*)(ws + WS_AMIX), (const bf16_t*)(ws + WS_WO), D, D, D, 0}; pg8::StaticOrder S; S.init(T / 256, D / 256, G, bx);
        pg8::EpiResF32 E{a.x, a.out, (bf16_t*)(ws + WS_AB), ctl + 2 * T};
        pg8::gemm_phase<pg8::EpiResF32, pg8::StaticOrder, true, true>(lds, g, S, E);
    }
    SEAM(4);
    if (IN(5)) {
        pg8::Gemm g{(const bf16_t*)(ws + WS_AB), (const bf16_t*)(ws + WS_WQ), D, D, D, 0}; pg8::StaticOrder S; S.init(T / 256, D / 256, G, bx);
        pg8::EpiBf16<D, true, false, false> E{(bf16_t*)(ws + WS_Q), ctl + 2 * T, 1.f / D, 1.f, nullptr, nullptr, nullptr};
        pg8::gemm_phase<pg8::EpiBf16<D, true, false, false>, pg8::StaticOrder, true, true>(lds, g, S, E);
    }
    if (IN(5)) {
        pg8::Gemm g{(const bf16_t*)(ws + WS_PB), (const bf16_t*)(ws + WS_WP), DPLE, DPLE, DPLE, 0}; pg8::StaticOrder S; S.init(T / 256, D / 256, G, bx);
        pg8::EpiBf16<D, false, false, false> E{(bf16_t*)(ws + WS_KV), nullptr, 0.f, 1.f, nullptr, nullptr, nullptr};
        pg8::gemm_phase<pg8::EpiBf16<D, false, false, false>, pg8::StaticOrder, true, true>(lds, g, S, E);
    }
    SEAM(5);
    if (IN(6)) {
        pg8::Gemm g{(const bf16_t*)(ws + WS_Q), (const bf16_t*)(ws + WS_SK), D, 256, 256, 256};
        pg8::EpiTopK E{(int*)(ws + WS_EID), (float*)(ws + WS_GATE)};
        for (int L = bx; L < (T / 256) * PH; L += G) { pg8::SingleUnit S; S.u0.pm = L >> 3; S.u0.pn = L & 7;
            pg8::gemm_phase<pg8::EpiTopK, pg8::SingleUnit, false, true>(lds, g, S, E); }
    }
    SEAM(6);
    if (IN(7)) { p6_experts(a, vcu, G, lane, wave); }
    SEAM(7);
    if (IN(8)) {
        pg8::Gemm g{(const bf16_t*)(ws + WS_AB), (const bf16_t*)(ws + WS_WG), D, D, D, 0}; pg8::StaticOrder S; S.init(T / 256, D / 256, G, bx);
        pg8::EpiPle E{a.out, (const bf16_t*)(ws + WS_KV), rinv_ple, ctl + 3 * T};
        pg8::gemm_phase<pg8::EpiPle, pg8::StaticOrder, true, true>(lds, g, S, E);
    }
    SEAM(8);
    if (IN(9)) { p8_final(a, vcu, G, lane, wave); }
#undef IN
#undef SEAM
}

extern "C" void kernel_launch(void* const* d_in, const int* in_sizes, int n_in, void* d_out, int out_size, void* d_ws, size_t ws_size, hipStream_t stream) {
    static int grid = 0;
    if (grid == 0) {
        if (n_in != 21 || out_size != T * D || ws_size < WS_END) { fprintf(stderr, "kernel_launch: unexpected shapes (n_in %d, out %d, ws %zu)\n", n_in, out_size, ws_size); grid = -1; return; }
        int dev = 0, cus = 0, per_cu = 0;
        hipGetDevice(&dev); hipDeviceGetAttribute(&cus, hipDeviceAttributeMultiprocessorCount, dev);
        if (hipFuncSetAttribute((const void*)hymba_fwd, hipFuncAttributeMaxDynamicSharedMemorySize, LDS_BYTES) != hipSuccess) { fprintf(stderr, "kernel_launch: hipFuncSetAttribute failed\n"); grid = -1; return; }
        if (hipOccupancyMaxActiveBlocksPerMultiprocessor(&per_cu, (const void*)hymba_fwd, NTHR, LDS_BYTES) != hipSuccess || per_cu < 1) { fprintf(stderr, "kernel_launch: occupancy query says %d\n", per_cu); grid = -1; (void)hipGetLastError(); return; }
        grid = cus;
    }
    if (grid < 0) return;
    Args a{};
    a.x = (const float*)d_in[0]; a.p = (const float*)d_in[1]; a.positions = (const int*)d_in[2]; a.mix_g = (const float*)d_in[3]; a.w_in = (const float*)d_in[4];
    a.pool_w = (const float*)d_in[5]; a.pool_scale = (const float*)d_in[6]; a.q_g = (const float*)d_in[7]; a.w_uq = (const float*)d_in[8]; a.kv_g = (const float*)d_in[9];
    a.w_ukv = (const float*)d_in[10]; a.w_o = (const float*)d_in[11]; a.ffn_g = (const float*)d_in[12]; a.peer_wq = (const float*)d_in[13]; a.sub_keys = (const float*)d_in[14];
    a.peer_u = (const float*)d_in[15]; a.peer_v = (const float*)d_in[16]; a.ple_g = (const float*)d_in[17]; a.ple_wg = (const float*)d_in[18]; a.ple_wp = (const float*)d_in[19];
    a.final_g = (const float*)d_in[20];
    a.out = (float*)d_out; a.ws = (unsigned char*)d_ws; a.ph_lo = 0; a.ph_hi = N_PHASES;
    void* args[] = {&a};
    hipError_t e = hipLaunchCooperativeKernel((const void*)hymba_fwd, dim3(grid), dim3(NTHR), args, LDS_BYTES, stream);
    if (e != hipSuccess) fprintf(stderr, "kernel_launch: cooperative launch failed: %s (grid %d)\n", hipGetErrorString(e), grid);
}
```

```cpp
#include <hip/hip_runtime.h>
#include <hip/hip_cooperative_groups.h>
#include <cstdio>
#include <cstdint>
namespace cg = cooperative_groups;

#define LAS __attribute__((address_space(3)))
typedef unsigned short bf16_t;
typedef short bf16x8 __attribute__((ext_vector_type(8)));
typedef float f32x4 __attribute__((ext_vector_type(4)));
typedef float f32x2 __attribute__((ext_vector_type(2)));
typedef unsigned u32x4 __attribute__((ext_vector_type(4)));
typedef unsigned u32x2 __attribute__((ext_vector_type(2)));
typedef int v4i32 __attribute__((ext_vector_type(4)));
typedef int v2i32 __attribute__((ext_vector_type(2)));
typedef int v8i32 __attribute__((ext_vector_type(8)));

constexpr int T = 32768, SEQ = 8192, NB = 4, D = 2048, DIN = 1600, DINP = 1792, DPOOL = 512, DPLE = 256;
constexpr int NH = 12, QKD = 192, NQ = NH * QKD  , NKV = NH * 256  , DATT = 1536;
constexpr int PH = 8, PK = 128, PTOP = 16, NEXP = 16384;
constexpr float EPS = 1e-6f;
constexpr int NWAVES = 8, NTHR = 512;

constexpr size_t MiB = 1u << 20;
constexpr size_t WS_CTL = 868 * MiB;
constexpr size_t WS_WIN = 1 * MiB;
constexpr size_t WS_WUQ = 8 * MiB;
constexpr size_t WS_WUKV = 11 * MiB;
constexpr size_t WS_WO = 14 * MiB;
constexpr size_t WS_WQ = 22 * MiB;
constexpr size_t WS_SK = 30 * MiB;
constexpr size_t WS_WG = 31 * MiB;
constexpr size_t WS_WP = 39 * MiB;
constexpr size_t WS_ROPE = 40 * MiB;
constexpr size_t WS_KR = 48 * MiB;
constexpr size_t WS_PB = 52 * MiB;
constexpr size_t WS_EID = 68 * MiB;
constexpr size_t WS_GATE = 84 * MiB;
constexpr size_t WS_UT = 100 * MiB;
constexpr size_t WS_VT = 132 * MiB;
constexpr size_t WS_AB = 164 * MiB;
constexpr size_t WS_Z = 292 * MiB;
constexpr size_t WS_Q = 404 * MiB;
constexpr size_t WS_KV = 548 * MiB;
constexpr size_t WS_AMIX = 740 * MiB;
constexpr size_t WS_BAR = WS_CTL + 3 * MiB / 2;
constexpr size_t WS_PROJ = 870 * MiB;
constexpr size_t WS_SU = WS_CTL + 13 * MiB / 8;
constexpr size_t WS_SV = WS_CTL + 14 * MiB / 8;
constexpr size_t WS_END = 998 * MiB;

#define ATTN_ZERO 0
#ifndef PROBE_PHASE
#define PROBE_PHASE -1
#endif
constexpr int LDS_BYTES = 148480;

typedef __bf16 bf16x2_t __attribute__((ext_vector_type(2)));
__device__ __forceinline__ unsigned cvt_pk_bf16(float lo, float hi) { f32x2 v = {lo, hi}; bf16x2_t b = __builtin_convertvector(v, bf16x2_t); return __builtin_bit_cast(unsigned, b); }
__device__ __forceinline__ float bf_lo(unsigned w) { return __uint_as_float(w << 16); }
__device__ __forceinline__ float bf_hi(unsigned w) { return __uint_as_float(w & 0xffff0000u); }
__device__ __forceinline__ float wave_sum(float v) {
#pragma unroll
    for (int o = 1; o < 64; o <<= 1) v += __shfl_xor(v, o);
    return v;
}
#define DPPF(v, ctrl) __builtin_bit_cast(float, __builtin_amdgcn_update_dpp(0, __builtin_bit_cast(int, (v)), (ctrl), 0xF, 0xF, true))
__device__ __forceinline__ float wave_sum_dpp(float v) {
    v += DPPF(v, 0xB1); v += DPPF(v, 0x4E); v += DPPF(v, 0x141); v += DPPF(v, 0x140);
    const int b = __builtin_bit_cast(int, v);
    return (__builtin_bit_cast(float, __builtin_amdgcn_readlane(b, 0)) + __builtin_bit_cast(float, __builtin_amdgcn_readlane(b, 16))) + (__builtin_bit_cast(float, __builtin_amdgcn_readlane(b, 32)) + __builtin_bit_cast(float, __builtin_amdgcn_readlane(b, 48)));
}
#define LDS_WAIT() asm volatile("s_waitcnt lgkmcnt(0)" ::: "memory")
typedef unsigned long long u64;
__device__ __forceinline__ void ssq_add(u64* p, float ss) { atomicAdd(p, (u64)(ss * 1048576.f + 0.5f)); }
__device__ __forceinline__ float ssq_get(const u64* p) { return (float)(*p) * (1.f / 1048576.f); }

namespace pg8 {
constexpr int BM = 256, BK = 64, HALF = 128, HTB = HALF * BK * 2, STAGE_BYTES = 8 * HTB, NXCD = 8, WGM = 8;
__host__ __device__ __forceinline__ int lds_byte(int r, int c) { const int st = (r >> 4) * 2 + (c >> 5), rr = r & 15, cc = c & 31, ob = rr * 64 + cc * 2; return st * 1024 + (ob ^ (((ob >> 9) & 1) << 5)); }
__host__ __device__ __forceinline__ void stage_rc(int b, int& R, int& C) { const int st = b / 1024, sb = b % 1024, swz = sb ^ (((sb >> 9) & 1) << 5); R = (st >> 1) * 16 + swz / 64; C = (st & 1) * 32 + (swz % 64) / 2; }
__host__ __device__ __forceinline__ int perm32(int rho) { const int n = rho >> 4, i = rho & 15; return 8 * (i >> 2) + 4 * n + (i & 3); }

struct Unit { int pm, pn; };
struct Gemm { const bf16_t* A; const bf16_t* Bt; int lda, ldb, K, acol_pn; };

struct StaticOrder {
    int nM, nN, nwg, G, c;
    __device__ void init(int nM_, int nN_, int G_, int c_) { nM = nM_; nN = nN_; nwg = nM * nN; G = G_; c = c_; }
    __device__ __forceinline__ bool next(int i, Unit& u) const {
        const long L = (long)i * G + c; if (L >= nwg) return false;
        int wgid = (int)L; { const int q = nwg / NXCD, r = nwg % NXCD, xcd = wgid % NXCD, off = wgid / NXCD; wgid = (xcd < r ? xcd * (q + 1) : r * (q + 1) + (xcd - r) * q) + off; }
        const int nig = WGM * nN, gid = wgid / nig, fm = gid * WGM, gsz = (nM - fm) < WGM ? (nM - fm) : WGM;
        u.pm = fm + ((wgid % nig) % gsz); u.pn = (wgid % nig) / gsz; return true;
    }
};
struct TailOrder {
    int nN, nwg, Gt, ct;
    __device__ void init(int nM_, int nN_, int G_, int c_, int c0) { nN = nN_; nwg = nM_ * nN_; Gt = G_ - c0; ct = c_ - c0; }
    __device__ bool next(int i, Unit& u) const { if (ct < 0) return false; const long L = (long)i * Gt + ct; if (L >= nwg) return false; u.pm = (int)L / nN; u.pn = (int)L % nN; return true; }
};
struct SingleUnit {
    Unit u0;
    __device__ bool next(int i, Unit& u) const { if (i > 0) return false; u = u0; return true; }
};

template <class Epi, class Sched, bool ALIGN_EPI, bool SP2, bool FP8 = false, int MIXK = 0>
__device__ __forceinline__ void gemm_phase(LAS unsigned char* lds, const Gemm g, const Sched& S, const Epi& E) {
    const int tid = threadIdx.x, wid = __builtin_amdgcn_readfirstlane(tid >> 6), lane = tid & 63, wr = wid >> 2, wc = wid & 3, fr = lane & 15, fq = lane >> 4;
    int K_ = g.K; asm volatile("" : "+s"(K_));
    const int K = K_, nt = K / BK;
    unsigned voffA[2], voffB[2];
#pragma unroll
    for (int i = 0; i < 2; ++i) { int R, C; stage_rc(tid * 16 + i * 8192, R, C); const int Rb = Epi::PERM ? ((R & ~31) + perm32(R & 31)) : R;
        voffA[i] = (unsigned)(R * g.lda + C) * 2u; voffB[i] = (unsigned)(Rb * g.ldb + C) * 2u; }
    const size_t kstep = (size_t)(BK * 2);
    const size_t hstepA = (size_t)HALF * g.lda * 2, hstepB = (size_t)HALF * g.ldb * 2;
    const size_t tstepA = 2 * hstepA, tstepB = 2 * hstepB;
    const unsigned ldsw = (unsigned)wid * 1024u;
    const int aoff = lds_byte(wr * 64 + fr, fq * 8), boff = lds_byte(wc * 32 + fr, fq * 8);
#define PG8_SA(b, h) (((b) * 2 + (h)) * HTB)
#define PG8_SB(b, h) ((4 + (b) * 2 + (h)) * HTB)
#define PG8_STAGE(bufoff, gbase, voff) do { _Pragma("unroll") for (int _i = 0; _i < 2; ++_i) \
        __builtin_amdgcn_global_load_lds((const unsigned*)((const char*)(gbase) + (voff)[_i]), (LAS unsigned*)(lds + (bufoff) + ldsw + _i * 8192), 16, 0, 0); } while (0)
#define PG8_LDA_(dst, b, h, F8) do { _Pragma("unroll") for (int m = 0; m < 4; ++m) { if constexpr (F8) { const v4i32 lo_ = *(const LAS v4i32*)(lds + PG8_SA(b, h) + aoff + m * 2048), hi_ = *(const LAS v4i32*)(lds + PG8_SA(b, h) + aoff + m * 2048 + 1024); \
            dst##8[m] = __builtin_shufflevector(lo_, hi_, 0, 1, 2, 3, 4, 5, 6, 7); } \
        else { _Pragma("unroll") for (int k = 0; k < 2; ++k) dst[m][k] = *(const LAS bf16x8*)(lds + PG8_SA(b, h) + aoff + m * 2048 + k * 1024); } } } while (0)
#define PG8_LDB_(dst, b, h, F8) do { _Pragma("unroll") for (int n = 0; n < 2; ++n) { if constexpr (F8) { const v4i32 lo_ = *(const LAS v4i32*)(lds + PG8_SB(b, h) + boff + n * 2048), hi_ = *(const LAS v4i32*)(lds + PG8_SB(b, h) + boff + n * 2048 + 1024); \
            dst##8[n] = __builtin_shufflevector(lo_, hi_, 0, 1, 2, 3, 4, 5, 6, 7); } \
        else { _Pragma("unroll") for (int k = 0; k < 2; ++k) dst[n][k] = *(const LAS bf16x8*)(lds + PG8_SB(b, h) + boff + n * 2048 + k * 1024); } } } while (0)
#define PG8_MMA_(ai, bj, At, Bt, F8) do { __builtin_amdgcn_s_setprio(1); _Pragma("unroll") for (int m = 0; m < 4; ++m) _Pragma("unroll") for (int n = 0; n < 2; ++n) { \
        if constexpr (F8) asm volatile("v_mfma_f32_16x16x128_f8f6f4 %0, %1, %2, %0" : "+v"(acc[ai][bj][m][n]) : "v"(Bt##8[n]), "v"(At##8[m]));     \
          \
          \
        else { _Pragma("unroll") for (int k = 0; k < 2; ++k) acc[ai][bj][m][n] = __builtin_amdgcn_mfma_f32_16x16x32_bf16(Bt[n][k], At[m][k], acc[ai][bj][m][n], 0, 0, 0); } } \
        __builtin_amdgcn_s_setprio(0); } while (0)
#define PG8_LDA(dst, b, h) PG8_LDA_(dst, b, h, FP8)
#define PG8_LDB(dst, b, h) PG8_LDB_(dst, b, h, FP8)
#define PG8_MMA(ai, bj, At, Bt) PG8_MMA_(ai, bj, At, Bt, FP8)
#define PG8_WAIT_V(n) asm volatile("s_waitcnt vmcnt(" #n ")" ::: "memory")
#define PG8_WAIT_L(n) asm volatile("s_waitcnt lgkmcnt(" #n ")" ::: "memory")
#define PG8_BAR __builtin_amdgcn_s_barrier()
#define PG8_SCHED __builtin_amdgcn_sched_barrier(0)
    Unit cur, nxt; int ui = 0;
    if (!S.next(0, cur)) return;
    f32x4 acc[2][2][4][2];
#pragma unroll
    for (int a = 0; a < 2; ++a)
#pragma unroll
        for (int b = 0; b < 2; ++b)
#pragma unroll
            for (int m = 0; m < 4; ++m)
#pragma unroll
                for (int n = 0; n < 2; ++n) acc[a][b][m][n] = (f32x4){0.f, 0.f, 0.f, 0.f};
    int one_e8m0 = 0x7f7f7f7f; asm volatile("" : "+v"(one_e8m0));
    bf16x8 At[4][2], B0[2][2], B1[2][2]; v8i32 At8[4], B08[2], B18[2];
    const char* cA = (const char*)g.A + (size_t)cur.pm * tstepA + (size_t)cur.pn * g.acol_pn * 2; const char* cB = (const char*)g.Bt + (size_t)cur.pn * tstepB;
    if constexpr (SP2) {
        PG8_STAGE(PG8_SB(0, 0), cB, voffB); PG8_STAGE(PG8_SB(0, 1), cB + hstepB, voffB); PG8_STAGE(PG8_SA(0, 0), cA, voffA); PG8_STAGE(PG8_SA(0, 1), cA + hstepA, voffA);
        if (wr == 1) PG8_BAR;
        PG8_WAIT_V(2); PG8_BAR;
        PG8_STAGE(PG8_SB(1, 0), cB + kstep, voffB); PG8_STAGE(PG8_SA(1, 0), cA + kstep, voffA); PG8_STAGE(PG8_SB(1, 1), cB + hstepB + kstep, voffB);
        PG8_WAIT_V(6); PG8_BAR;
    } else {
        PG8_STAGE(PG8_SB(0, 0), cB, voffB); PG8_STAGE(PG8_SA(0, 0), cA, voffA); PG8_STAGE(PG8_SB(0, 1), cB + hstepB, voffB); PG8_STAGE(PG8_SA(0, 1), cA + hstepA, voffA);
        if (wr == 1) PG8_BAR;
        PG8_WAIT_V(4); PG8_BAR;
        PG8_STAGE(PG8_SB(1, 0), cB + kstep, voffB); PG8_STAGE(PG8_SA(1, 0), cA + kstep, voffA); PG8_STAGE(PG8_SB(1, 1), cB + hstepB + kstep, voffB);
        PG8_WAIT_V(6); PG8_BAR;
    }
    for (;;) {
        const bool has_next = S.next(ui + 1, nxt);
        const char* nA = has_next ? (const char*)g.A + (size_t)nxt.pm * tstepA + (size_t)nxt.pn * g.acol_pn * 2 : cA; const char* nB = has_next ? (const char*)g.Bt + (size_t)nxt.pn * tstepB : cB;
#define PG8_SP2_TRIP(F8) do { \
            PG8_LDB_(B0, 0, 0, F8); PG8_LDB_(B1, 0, 1, F8); PG8_SCHED; PG8_LDA_(At, 0, 0, F8); PG8_STAGE(PG8_SA(1, 1), a1 + hstepA, voffA); \
            PG8_WAIT_V(8); PG8_WAIT_L(0); PG8_BAR; PG8_MMA_(0, 0, At, B0, F8); PG8_MMA_(0, 1, At, B1, F8); PG8_BAR; PG8_SCHED; \
            PG8_LDA_(At, 0, 1, F8); PG8_STAGE(PG8_SB(0, 0), b2, voffB); PG8_STAGE(PG8_SB(0, 1), b2 + hstepB, voffB); PG8_STAGE(PG8_SA(0, 0), a2, voffA); \
            PG8_WAIT_V(8); PG8_WAIT_L(0); PG8_BAR; PG8_MMA_(1, 0, At, B0, F8); PG8_MMA_(1, 1, At, B1, F8); PG8_BAR; PG8_SCHED; \
            PG8_LDB_(B0, 1, 0, F8); PG8_LDB_(B1, 1, 1, F8); PG8_SCHED; PG8_LDA_(At, 1, 0, F8); PG8_STAGE(PG8_SA(0, 1), a2 + hstepA, voffA); \
            PG8_WAIT_V(8); PG8_WAIT_L(0); PG8_BAR; PG8_MMA_(0, 0, At, B0, F8); PG8_MMA_(0, 1, At, B1, F8); PG8_BAR; PG8_SCHED; \
            PG8_LDA_(At, 1, 1, F8); PG8_STAGE(PG8_SB(1, 0), b3, voffB); PG8_STAGE(PG8_SB(1, 1), b3 + hstepB, voffB); PG8_STAGE(PG8_SA(1, 0), a3, voffA); \
            PG8_WAIT_V(8); PG8_WAIT_L(0); PG8_BAR; PG8_MMA_(1, 0, At, B0, F8); PG8_MMA_(1, 1, At, B1, F8); PG8_BAR; PG8_SCHED; } while (0)
#define PG8_ADDR const bool last = (t == nt - 2); const char* a1 = cA + (size_t)(t + 1) * kstep; \
            const char* a2 = last ? nA : cA + (size_t)(t + 2) * kstep; const char* b2 = last ? nB : cB + (size_t)(t + 2) * kstep; \
            const char* a3 = a2 + kstep; const char* b3 = b2 + kstep;
        int tmix = MIXK; asm volatile("" : "+s"(tmix));
        if constexpr (SP2 && MIXK > 0) { for (int t = 0; t < tmix; t += 2) { PG8_ADDR PG8_SP2_TRIP(false); } }
        for (int t = (SP2 && MIXK > 0) ? tmix : 0; t < nt; t += 2) {
            PG8_ADDR
            if constexpr (SP2) {
            if constexpr (MIXK > 0) PG8_SP2_TRIP(true); else PG8_SP2_TRIP(FP8);
            } else {
            PG8_LDB(B0, 0, 0); PG8_SCHED; PG8_LDA(At, 0, 0); PG8_STAGE(PG8_SA(1, 1), a1 + hstepA, voffA);
            PG8_WAIT_L(8); PG8_BAR; PG8_WAIT_L(0); PG8_MMA(0, 0, At, B0); PG8_BAR; PG8_SCHED;
            PG8_LDB(B1, 0, 1); PG8_STAGE(PG8_SB(0, 0), b2, voffB);
            PG8_BAR; PG8_WAIT_L(0); PG8_MMA(0, 1, At, B1); PG8_BAR;
            PG8_LDA(At, 0, 1); PG8_STAGE(PG8_SA(0, 0), a2, voffA);
            PG8_BAR; PG8_WAIT_L(0); PG8_MMA(1, 0, At, B0); PG8_BAR; PG8_SCHED;
            PG8_STAGE(PG8_SB(0, 1), b2 + hstepB, voffB);
            PG8_WAIT_V(6); PG8_BAR; PG8_MMA(1, 1, At, B1); PG8_BAR;
            PG8_LDB(B0, 1, 0); PG8_SCHED; PG8_LDA(At, 1, 0); PG8_STAGE(PG8_SA(0, 1), a2 + hstepA, voffA);
            PG8_WAIT_L(8); PG8_BAR; PG8_WAIT_L(0); PG8_MMA(0, 0, At, B0); PG8_BAR; PG8_SCHED;
            PG8_LDB(B1, 1, 1); PG8_STAGE(PG8_SB(1, 0), b3, voffB);
            PG8_BAR; PG8_WAIT_L(0); PG8_MMA(0, 1, At, B1); PG8_BAR;
            PG8_LDA(At, 1, 1); PG8_STAGE(PG8_SA(1, 0), a3, voffA);
            PG8_BAR; PG8_WAIT_L(0); PG8_MMA(1, 0, At, B0); PG8_BAR; PG8_SCHED;
            PG8_STAGE(PG8_SB(1, 1), b3 + hstepB, voffB);
            PG8_WAIT_V(6); PG8_BAR; PG8_MMA(1, 1, At, B1); PG8_BAR;
            }
        }
        if constexpr (ALIGN_EPI) { if (wr == 0) PG8_BAR; }
        if constexpr (FP8 || MIXK > 0) asm volatile("s_nop 15\n\ts_nop 7" ::: "memory");
        if constexpr (!Epi::AFTER_DRAIN) { E(acc, cur, wr, wc, fr, fq); }
        if (!has_next) break;
#pragma unroll
        for (int a = 0; a < 2; ++a)
#pragma unroll
            for (int b = 0; b < 2; ++b)
#pragma unroll
                for (int m = 0; m < 4; ++m)
#pragma unroll
                    for (int n = 0; n < 2; ++n) acc[a][b][m][n] = (f32x4){0.f, 0.f, 0.f, 0.f};
        cur = nxt; cA = nA; cB = nB; ++ui;
        if constexpr (ALIGN_EPI) { if (wr == 1) PG8_BAR; }
    }
    PG8_WAIT_V(0);
    if constexpr (!ALIGN_EPI) { if (wr == 0) PG8_BAR; }
    PG8_BAR;
    if constexpr (Epi::AFTER_DRAIN) { E.fused(acc, cur, wr, wc, fr, fq, lds, wid, lane); }
#undef PG8_SA
#undef PG8_SB
#undef PG8_STAGE
#undef PG8_LDA
#undef PG8_LDB
#undef PG8_MMA
#undef PG8_LDA_
#undef PG8_LDB_
#undef PG8_MMA_
#undef PG8_SP2_TRIP
#undef PG8_ADDR
#undef PG8_WAIT_V
#undef PG8_WAIT_L
#undef PG8_BAR
#undef PG8_SCHED
}


__device__ __forceinline__ void row_ssq_flush(LAS unsigned char* lds, const float (&ss)[2][4], int pm, int wr, int wc, int fr, int fq, u64* dst) {
    LAS float* P = (LAS float*)(lds + STAGE_BYTES);
    if (fq == 0) {
#pragma unroll
        for (int ai = 0; ai < 2; ++ai)
#pragma unroll
            for (int m = 0; m < 4; ++m) P[(ai * HALF + wr * 64 + m * 16 + fr) * 4 + wc] = ss[ai][m]; }
    asm volatile("s_waitcnt lgkmcnt(0)" ::: "memory"); __builtin_amdgcn_s_barrier(); asm volatile("" ::: "memory");
    const int tid = (wr * 4 + wc) * 64 + fq * 16 + fr;
    if (tid < 256) { const f32x4 p = *(const LAS f32x4*)(P + tid * 4); ssq_add(dst + pm * BM + tid, (p[0] + p[1]) + (p[2] + p[3])); }
}


template <int LDC, bool RS, bool SSQ, bool ROPE, int F8MODE = 0> struct EpiBf16 {
    static constexpr bool PERM = true, AFTER_DRAIN = false;
    bf16_t* O; const u64* ssq_in; float inv_n, mul; u64* ssq_a; u64* ssq_b; const float* rope; LAS unsigned char* lds; unsigned char* O8;
    __device__ __forceinline__ void store_vt(const f32x4 (&acc)[2][2][4][2], const Unit& u, int wr, int wc, int fr, int fq, const float (&scl)[2][4]) const {
        LAS unsigned char* VL = lds + STAGE_BYTES; const int tid = (wr * 4 + wc) * 64 + fq * 16 + fr;
#pragma unroll
        for (int cs = 0; cs < 4; ++cs) { const int ai = cs >> 1, wrs = cs & 1;
            if (wr == wrs) {
#pragma unroll
                for (int m = 0; m < 4; ++m) { const int key = 16 * m + fr, k32 = key & 31, pos = 32 * ((k32 >> 2) & 1) + 16 * (key >> 5) + 4 * (k32 >> 3) + (k32 & 3); const float sc = scl[ai][m] * 32.f;
#pragma unroll
                    for (int bj = 0; bj < 2; ++bj)
#pragma unroll
                        for (int n = 0; n < 2; ++n) { const f32x4 v = acc[ai][bj][m][n] * sc; const int d = 32 * wc + 8 * fq + 4 * n;
                            const unsigned w01 = (unsigned)__builtin_amdgcn_cvt_pk_fp8_f32(v[0], v[1], 0, false), w23 = (unsigned)__builtin_amdgcn_cvt_pk_fp8_f32(v[2], v[3], 0, false);
                            LAS unsigned char* q = VL + (bj * 128 + d) * 64 + pos;
                            q[0] = (unsigned char)(w01 & 0xffu); q[64] = (unsigned char)((w01 >> 8) & 0xffu); q[128] = (unsigned char)(w23 & 0xffu); q[192] = (unsigned char)((w23 >> 8) & 0xffu); } } }
            asm volatile("s_waitcnt lgkmcnt(0)" ::: "memory"); __builtin_amdgcn_s_barrier(); asm volatile("" ::: "memory");
            { const int token0 = u.pm * BM + 64 * cs, bb = token0 / SEQ, tile = (token0 % SEQ) / 64, bjc = tid >> 8, off = (tid & 255) * 32, hd = 2 * (u.pn - 6) + bjc;
              unsigned char* dst = (unsigned char*)O + ((size_t)(bb * NH + hd) * (SEQ / 64) + tile) * 8192 + off;
              const u32x4 x0 = *(const LAS u32x4*)(VL + bjc * 8192 + off), x1 = *(const LAS u32x4*)(VL + bjc * 8192 + off + 16);
              *(u32x4*)dst = x0; *(u32x4*)(dst + 16) = x1; }
            asm volatile("s_waitcnt lgkmcnt(0)" ::: "memory"); __builtin_amdgcn_s_barrier(); asm volatile("" ::: "memory");
        }
    }
    __device__ __forceinline__ void operator()(const f32x4 (&acc)[2][2][4][2], const Unit& u, int wr, int wc, int fr, int fq) const {
        const int row0 = u.pm * BM + wr * 64 + fr, col0 = u.pn * BM + wc * 32 + 8 * fq;
        const bool do_ssq = SSQ && u.pn >= 2 && u.pn < 6; float ssr[2][4];
        float scl[2][4];
        if constexpr (RS) { u64 q8[2][4];
#pragma unroll
            for (int ai = 0; ai < 2; ++ai)
#pragma unroll
                for (int m = 0; m < 4; ++m) q8[ai][m] = ssq_in[row0 + ai * HALF + m * 16];
#pragma unroll
            for (int ai = 0; ai < 2; ++ai)
#pragma unroll
                for (int m = 0; m < 4; ++m) scl[ai][m] = mul * rsqrtf((float)q8[ai][m] * (1.f / 1048576.f) * inv_n + EPS); }
        if constexpr (F8MODE == 3) { if (u.pn >= 6) { store_vt(acc, u, wr, wc, fr, fq, scl); return; } }
#pragma unroll
        for (int ai = 0; ai < 2; ++ai) {
#pragma unroll
            for (int m = 0; m < 4; ++m) {
                const int row = row0 + ai * HALF + m * 16;
                float sc = mul; if constexpr (RS) sc = scl[ai][m];
                float ss = 0.f;
#pragma unroll
                for (int bj = 0; bj < 2; ++bj) {
                    f32x4 v0 = acc[ai][bj][m][0] * sc, v1 = acc[ai][bj][m][1] * sc; const int col = col0 + bj * HALF;
                    if constexpr (ROPE) { const int cw = col % QKD;
                        if (cw >= 128) { const int i0 = (cw - 128) >> 1; const f32x4 cs = *(const f32x4*)(rope + (size_t)row * 64 + i0), sn = *(const f32x4*)(rope + (size_t)row * 64 + 32 + i0);
                            f32x4 a, b;
                            a[0] = v0[0] * cs[0] - v0[1] * sn[0]; a[1] = v0[1] * cs[0] + v0[0] * sn[0]; a[2] = v0[2] * cs[1] - v0[3] * sn[1]; a[3] = v0[3] * cs[1] + v0[2] * sn[1];
                            b[0] = v1[0] * cs[2] - v1[1] * sn[2]; b[1] = v1[1] * cs[2] + v1[0] * sn[2]; b[2] = v1[2] * cs[3] - v1[3] * sn[3]; b[3] = v1[3] * cs[3] + v1[2] * sn[3];
                            v0 = a; v1 = b; } }
                    if constexpr (SSQ) ss += (v0[0] * v0[0] + v0[1] * v0[1]) + (v0[2] * v0[2] + v0[3] * v0[3]) + (v1[0] * v1[0] + v1[1] * v1[1]) + (v1[2] * v1[2] + v1[3] * v1[3]);
                    const bool f8t = (F8MODE == 1 && do_ssq) || F8MODE == 2 || (F8MODE == 3 && u.pn < 6);
                    if (f8t) { const float fs = (F8MODE == 2) ? 1.f : 32.f;
                        int w0 = __builtin_amdgcn_cvt_pk_fp8_f32(v0[0] * fs, v0[1] * fs, 0, false); w0 = __builtin_amdgcn_cvt_pk_fp8_f32(v0[2] * fs, v0[3] * fs, w0, true);
                        int w1 = __builtin_amdgcn_cvt_pk_fp8_f32(v1[0] * fs, v1[1] * fs, 0, false); w1 = __builtin_amdgcn_cvt_pk_fp8_f32(v1[2] * fs, v1[3] * fs, w1, true);
                        unsigned char* dst = (F8MODE == 1) ? O8 + (size_t)row * 1024 + (col - 512) : O8 + (size_t)row * LDC + col;
                        *(u32x2*)dst = (u32x2){(unsigned)w0, (unsigned)w1}; }
                    else { u32x4 w; w.x = cvt_pk_bf16(v0[0], v0[1]); w.y = cvt_pk_bf16(v0[2], v0[3]); w.z = cvt_pk_bf16(v1[0], v1[1]); w.w = cvt_pk_bf16(v1[2], v1[3]);
                        *(u32x4*)(O + (size_t)row * LDC + (F8MODE == 3 ? col - 1536 : col)) = w; }
                }
                if constexpr (SSQ) { ss += __shfl_xor(ss, 16); ss += __shfl_xor(ss, 32); ssr[ai][m] = ss; }
                if constexpr (ROPE) asm volatile("" ::: "memory");
            }
            asm volatile("" ::: "memory");
        }
        if constexpr (SSQ) { if (do_ssq) row_ssq_flush(lds, ssr, u.pm, wr, wc, fr, fq, u.pn < 4 ? ssq_a : ssq_b); }
    }
};

struct EpiResF32 {
    static constexpr bool PERM = false, AFTER_DRAIN = false;
    bf16_t* io; const float* rms; u64* ssq; LAS unsigned char* lds; float ascale;
    __device__ __forceinline__ void operator()(const f32x4 (&acc)[2][2][4][2], const Unit& u, int wr, int wc, int fr, int fq) const {
        const int row0 = u.pm * BM + wr * 64 + fr, col0 = u.pn * BM + wc * 32 + 4 * fq; float ssr[2][4];
#pragma unroll
        for (int ai = 0; ai < 2; ++ai)
#pragma unroll
            for (int mp = 0; mp < 2; ++mp) { u32x2 xin[2][2][2]; float rm[2];
#pragma unroll
                for (int mm = 0; mm < 2; ++mm) { const int row = row0 + ai * HALF + (2 * mp + mm) * 16; rm[mm] = rms[row];
#pragma unroll
                    for (int bj = 0; bj < 2; ++bj)
#pragma unroll
                        for (int n = 0; n < 2; ++n) xin[mm][bj][n] = *(const u32x2*)(io + (size_t)row * D + col0 + bj * HALF + n * 16); }
#pragma unroll
                for (int mm = 0; mm < 2; ++mm) { const int m = 2 * mp + mm, row = row0 + ai * HALF + m * 16; float ss = 0.f;
#pragma unroll
                    for (int bj = 0; bj < 2; ++bj)
#pragma unroll
                        for (int n = 0; n < 2; ++n) { const u32x2 xw = xin[mm][bj][n]; const f32x4 v = (f32x4){bf_lo(xw.x), bf_hi(xw.x), bf_lo(xw.y), bf_hi(xw.y)} * rm[mm] + acc[ai][bj][m][n] * ascale;
                            u32x2 w; w.x = cvt_pk_bf16(v[0], v[1]); w.y = cvt_pk_bf16(v[2], v[3]); *(u32x2*)(io + (size_t)row * D + col0 + bj * HALF + n * 16) = w;
                            ss += (v[0] * v[0] + v[1] * v[1]) + (v[2] * v[2] + v[3] * v[3]); }
                    ss += __shfl_xor(ss, 16); ss += __shfl_xor(ss, 32); ssr[ai][m] = ss; }
                asm volatile("" ::: "memory");
            }
        row_ssq_flush(lds, ssr, u.pm, wr, wc, fr, fq, ssq);
    }
};

struct EpiPle {
    static constexpr bool PERM = false, AFTER_DRAIN = false;
    const bf16_t* hin; bf16_t* hout; const bf16_t* proj; const float* ssqp; u64* ssq; LAS unsigned char* lds; float ascale;
    __device__ __forceinline__ void operator()(const f32x4 (&acc)[2][2][4][2], const Unit& u, int wr, int wc, int fr, int fq) const {
        const int row0 = u.pm * BM + wr * 64 + fr, col0 = u.pn * BM + wc * 32 + 4 * fq; float ssr[2][4];
        LAS float* R = (LAS float*)(lds + STAGE_BYTES + 4096);
        { const int tid = (wr * 4 + wc) * 64 + fq * 16 + fr;
          if (tid < 256) { float sq = 0.f;
#pragma unroll
              for (int sl = 0; sl < 8; ++sl) sq += ssqp[(size_t)sl * T + u.pm * BM + tid];
              R[tid] = rsqrtf(sq * (1.f / D) + EPS) * ascale; }
          asm volatile("s_waitcnt lgkmcnt(0)" ::: "memory"); __builtin_amdgcn_s_barrier(); asm volatile("" ::: "memory"); }
#pragma unroll
        for (int ai = 0; ai < 2; ++ai)
#pragma unroll
            for (int m = 0; m < 4; ++m) {
                const int row = row0 + ai * HALF + m * 16; const size_t off = (size_t)row * D + col0; float ss = 0.f; const float ri = R[ai * HALF + wr * 64 + m * 16 + fr];
#pragma unroll
                for (int bj = 0; bj < 2; ++bj)
#pragma unroll
                    for (int n = 0; n < 2; ++n) { const size_t o = off + bj * HALF + n * 16; const u32x2 hw = *(const u32x2*)(hin + o); const u32x2 pw = *(const u32x2*)(proj + o);
                        const f32x4 a = acc[ai][bj][m][n] * ri; f32x4 v;
                        v[0] = bf_lo(hw.x) + bf_lo(pw.x) / (1.f + __expf(-a[0])); v[1] = bf_hi(hw.x) + bf_hi(pw.x) / (1.f + __expf(-a[1]));
                        v[2] = bf_lo(hw.y) + bf_lo(pw.y) / (1.f + __expf(-a[2])); v[3] = bf_hi(hw.y) + bf_hi(pw.y) / (1.f + __expf(-a[3]));
                        u32x2 w; w.x = cvt_pk_bf16(v[0], v[1]); w.y = cvt_pk_bf16(v[2], v[3]); *(u32x2*)(hout + o) = w;
                        ss += (v[0] * v[0] + v[1] * v[1]) + (v[2] * v[2] + v[3] * v[3]); }
                ss += __shfl_xor(ss, 16); ss += __shfl_xor(ss, 32); ssr[ai][m] = ss;
                asm volatile("" ::: "memory");
            }
        row_ssq_flush(lds, ssr, u.pm, wr, wc, fr, fq, ssq);
    }
};

__device__ __forceinline__ float fmax_s(float a, float b) { float d; asm("v_max_f32 %0, %1, %2" : "=v"(d) : "v"(a), "v"(b)); return d; }
__device__ __forceinline__ float fmin_s(float a, float b) { float d; asm("v_min_f32 %0, %1, %2" : "=v"(d) : "v"(a), "v"(b)); return d; }
__device__ __forceinline__ float keyf(float v, unsigned keep, unsigned idx) { return __uint_as_float((__float_as_uint(v) & keep) | idx); }
__device__ __forceinline__ float valf(float k, unsigned keep) { return __uint_as_float(__float_as_uint(k) & keep); }
__device__ __forceinline__ void ins16(float (&L)[16], float x) {
#pragma unroll
    for (int i = 0; i < 16; ++i) { const float hi = fmax_s(L[i], x); x = fmin_s(L[i], x); L[i] = hi; }
}
#define CE(a_, b_) do { const float hi_ = fmax_s((a_), (b_)), lo_ = fmin_s((a_), (b_)); (a_) = hi_; (b_) = lo_; } while (0)
#define SORT16(S) do { CE(S[0], S[1]); CE(S[2], S[3]); CE(S[0], S[2]); CE(S[1], S[3]); CE(S[1], S[2]); CE(S[4], S[5]); CE(S[6], S[7]); CE(S[4], S[6]); CE(S[5], S[7]); CE(S[5], S[6]); CE(S[0], S[4]); CE(S[2], S[6]); CE(S[2], S[4]); CE(S[1], S[5]); CE(S[3], S[7]); CE(S[3], S[5]); CE(S[1], S[2]); CE(S[3], S[4]); CE(S[5], S[6]); CE(S[8], S[9]); CE(S[10], S[11]); CE(S[8], S[10]); CE(S[9], S[11]); CE(S[9], S[10]); CE(S[12], S[13]); CE(S[14], S[15]); CE(S[12], S[14]); CE(S[13], S[15]); CE(S[13], S[14]); CE(S[8], S[12]); CE(S[10], S[14]); CE(S[10], S[12]); CE(S[9], S[13]); CE(S[11], S[15]); CE(S[11], S[13]); CE(S[9], S[10]); CE(S[11], S[12]); CE(S[13], S[14]); CE(S[0], S[8]); CE(S[4], S[12]); CE(S[4], S[8]); CE(S[2], S[10]); CE(S[6], S[14]); CE(S[6], S[10]); CE(S[2], S[4]); CE(S[6], S[8]); CE(S[10], S[12]); CE(S[1], S[9]); CE(S[5], S[13]); CE(S[5], S[9]); CE(S[3], S[11]); CE(S[7], S[15]); CE(S[7], S[11]); CE(S[3], S[5]); CE(S[7], S[9]); CE(S[11], S[13]); CE(S[1], S[2]); CE(S[3], S[4]); CE(S[5], S[6]); CE(S[7], S[8]); CE(S[9], S[10]); CE(S[11], S[12]); CE(S[13], S[14]); } while (0)
#define MERGE16(L, S) do { _Pragma("unroll") for (int i_ = 0; i_ < 16; ++i_) L[i_] = fmax_s(L[i_], S[15 - i_]); \
        _Pragma("unroll") for (int st_ = 8; st_ >= 1; st_ >>= 1) _Pragma("unroll") for (int i_ = 0; i_ < 16; ++i_) if (!(i_ & st_)) CE(L[i_], L[i_ + st_]); } while (0)
struct EpiTopK {
    static constexpr bool PERM = false, AFTER_DRAIN = true;
    unsigned short* eid; float* gate;
    __device__ __forceinline__ void fused(f32x4 (&acc)[2][2][4][2], const Unit& u, int wr, int wc, int fr, int fq, LAS unsigned char* lds, int wid, int lane) const {
        LAS float* SL = (LAS float*)lds;
        LAS unsigned char* TAB = lds + 512 * 272;
        const int tid = wid * 64 + lane, pp = (tid >> 1) & 1, rowl = tid >> 2; int half = tid & 1; asm volatile("" : "+v"(half));
        float OWN[16], SND[16];
#pragma unroll
        for (int ai = 0; ai < 2; ++ai) {
#pragma unroll
            for (int m = 0; m < 4; ++m)
#pragma unroll
                for (int bj = 0; bj < 2; ++bj)
#pragma unroll
                    for (int n = 0; n < 2; ++n) { const int r = 64 * wr + 16 * m + fr, c = 32 * wc + 16 * n + 4 * fq; const int list = r * 4 + bj * 2 + (c >> 6);
                        *(LAS f32x4*)(SL + list * 68 + (c & 63)) = acc[ai][bj][m][n]; }
            asm volatile("s_waitcnt lgkmcnt(0)" ::: "memory"); __builtin_amdgcn_s_barrier(); asm volatile("" ::: "memory");
            float L[16];
            { const LAS float* mine = SL + tid * 68; const int ib = 127 - half * 64;
#pragma unroll
              for (int gI = 0; gI < 4; ++gI) { float S[16];
#pragma unroll
                  for (int k4 = 0; k4 < 4; ++k4) { const f32x4 v = *(const LAS f32x4*)(mine + 16 * gI + 4 * k4);
#pragma unroll
                      for (int e = 0; e < 4; ++e) S[4 * k4 + e] = keyf(v[e], ~127u, (unsigned)(ib - 16 * gI - 4 * k4 - e)); }
                  SORT16(S);
                  if (gI == 0) {
#pragma unroll
                      for (int i = 0; i < 16; ++i) L[i] = S[i]; }
                  else MERGE16(L, S); } }
            float M[16];
#pragma unroll
            for (int i = 0; i < 16; ++i) { const float o = __int_as_float(__builtin_amdgcn_update_dpp(0, __float_as_int(L[15 - i]), 0xB1, 0xF, 0xF, true)); M[i] = fmax_s(L[i], o); }
#pragma unroll
            for (int st = 8; st >= 1; st >>= 1)
#pragma unroll
                for (int i = 0; i < 16; ++i) if (!(i & st)) CE(M[i], M[i + st]);
            if (half == 0) {
#pragma unroll
                for (int i = 0; i < 16; ++i) TAB[((ai * 128 + rowl) * 2 + pp) * 16 + i] = (unsigned char)(127u - (__float_as_uint(M[i]) & 127u)); }
#pragma unroll
            for (int i = 0; i < 16; ++i) { if (ai == 0) { OWN[i] = M[i]; SND[i] = M[i]; } else { OWN[i] = pp ? M[i] : OWN[i]; SND[i] = pp ? SND[i] : M[i]; } }
            asm volatile("s_waitcnt lgkmcnt(0)" ::: "memory"); __builtin_amdgcn_s_barrier(); asm volatile("" ::: "memory");
        }
        {
            const int ai = pp;
            float va[16], vb[16];
#pragma unroll
            for (int i = 0; i < 16; ++i) { const float oth = __int_as_float(__builtin_amdgcn_update_dpp(0, __float_as_int(SND[i]), 0x4E, 0xF, 0xF, true));
                va[i] = valf(pp ? oth : OWN[i], ~127u); vb[i] = valf(pp ? OWN[i] : oth, ~127u); }
            float C[16];
#pragma unroll
            for (int y = 0; y < 16; ++y) C[y] = keyf(va[0] + vb[y], ~255u, (unsigned)(255 - y));
            { float S[16];
              S[0] = keyf(va[1] + vb[0], ~255u, 239u);
              S[1] = keyf(va[1] + vb[1], ~255u, 238u);
              S[2] = keyf(va[1] + vb[2], ~255u, 237u);
              S[3] = keyf(va[1] + vb[3], ~255u, 236u);
              S[4] = keyf(va[1] + vb[4], ~255u, 235u);
              S[5] = keyf(va[1] + vb[5], ~255u, 234u);
              S[6] = keyf(va[1] + vb[6], ~255u, 233u);
              S[7] = keyf(va[1] + vb[7], ~255u, 232u);
              S[8] = keyf(va[2] + vb[0], ~255u, 223u);
              S[9] = keyf(va[2] + vb[1], ~255u, 222u);
              S[10] = keyf(va[2] + vb[2], ~255u, 221u);
              S[11] = keyf(va[2] + vb[3], ~255u, 220u);
              S[12] = keyf(va[2] + vb[4], ~255u, 219u);
              S[13] = keyf(va[3] + vb[0], ~255u, 207u);
              S[14] = keyf(va[3] + vb[1], ~255u, 206u);
              S[15] = keyf(va[3] + vb[2], ~255u, 205u);
              SORT16(S); MERGE16(C, S); }
            { float S[16];
              S[0] = keyf(va[3] + vb[3], ~255u, 204u);
              S[1] = keyf(va[4] + vb[0], ~255u, 191u);
              S[2] = keyf(va[4] + vb[1], ~255u, 190u);
              S[3] = keyf(va[4] + vb[2], ~255u, 189u);
              S[4] = keyf(va[5] + vb[0], ~255u, 175u);
              S[5] = keyf(va[5] + vb[1], ~255u, 174u);
              S[6] = keyf(va[6] + vb[0], ~255u, 159u);
              S[7] = keyf(va[6] + vb[1], ~255u, 158u);
              S[8] = keyf(va[7] + vb[0], ~255u, 143u);
              S[9] = keyf(va[7] + vb[1], ~255u, 142u);
              S[10] = keyf(va[8] + vb[0], ~255u, 127u);
              S[11] = keyf(va[9] + vb[0], ~255u, 111u);
              S[12] = keyf(va[10] + vb[0], ~255u, 95u);
              S[13] = keyf(va[11] + vb[0], ~255u, 79u);
              S[14] = keyf(va[12] + vb[0], ~255u, 63u);
              S[15] = keyf(va[13] + vb[0], ~255u, 47u);
              SORT16(S); MERGE16(C, S); }
            ins16(C, keyf(va[14] + vb[0], ~255u, 31u));
            ins16(C, keyf(va[15] + vb[0], ~255u, 15u));
            asm volatile("s_waitcnt lgkmcnt(0)" ::: "memory");
            if ((tid & 1) == 0) {
                const int token = u.pm * BM + ai * HALF + rowl; const size_t ob = (size_t)token * 128 + u.pn * 16;
                const float vmax = valf(C[0], ~255u); float ex[16], sum = 0.f; int ee[16];
#pragma unroll
                for (int k = 0; k < 16; ++k) { ex[k] = __expf(valf(C[k], ~255u) - vmax); sum += ex[k]; const unsigned code = 255u - (__float_as_uint(C[k]) & 255u);
                    ee[k] = (int)TAB[((ai * 128 + rowl) * 2 + 0) * 16 + (code >> 4)] * 128 + (int)TAB[((ai * 128 + rowl) * 2 + 1) * 16 + (code & 15u)]; }
                const float is = 1.f / sum;
#pragma unroll
                for (int k4 = 0; k4 < 4; ++k4) { *(f32x4*)(gate + ob + 4 * k4) = (f32x4){ex[4 * k4] * is, ex[4 * k4 + 1] * is, ex[4 * k4 + 2] * is, ex[4 * k4 + 3] * is};
                    *(u32x2*)(eid + ob + 4 * k4) = (u32x2){(unsigned)ee[4 * k4] | ((unsigned)ee[4 * k4 + 1] << 16), (unsigned)ee[4 * k4 + 2] | ((unsigned)ee[4 * k4 + 3] << 16)}; }
            }
            asm volatile("s_waitcnt lgkmcnt(0)" ::: "memory"); __builtin_amdgcn_s_barrier(); asm volatile("" ::: "memory");
        }
    }
};
}


namespace att {
typedef short s16x4 __attribute__((ext_vector_type(4)));
typedef float f32x16 __attribute__((ext_vector_type(16)));
constexpr int KVBLK = 64, SHM_V = 8192, SHM_KN = 8192, SHM_KR = 4096;
constexpr int OFF_KN = 0, OFF_KR = 2 * SHM_KN, OFF_V = OFF_KR + 2 * SHM_KR, OFF_WS = OFF_V + 2 * SHM_V, LDS_NEED = OFF_WS + NWAVES * 64 * 4;
#define KSWZ8(row, chunk) ((row) * 128 + (((chunk) ^ (((row) >> 1) & 7)) << 4))
#define KRSWZ8(row, chunk) ((row) * 64 + (((chunk) ^ (((row) >> 2) & 3)) << 4))
#define SBAR() __builtin_amdgcn_sched_barrier(0)
#define VSWZ8(row, chunk) ((row) * 64 + (((chunk) ^ (((row) >> 2) & 3)) << 4))
__device__ __forceinline__ int crow(int r, int hi) { return (r & 3) + 8 * (r >> 2) + 4 * hi; }
__device__ __forceinline__ unsigned cvtpk(float lo, float hi) { unsigned r; asm volatile("v_cvt_pk_bf16_f32 %0, %1, %2" : "=v"(r) : "v"(lo), "v"(hi)); return r; }
__device__ __forceinline__ float fsub_s(float a, float b) { float d; asm volatile("v_sub_f32 %0, %1, %2" : "=v"(d) : "v"(a), "v"(b)); return d; }
__device__ __forceinline__ float fexp2sub_s(float a, float b) { float d; asm volatile("v_sub_f32 %0, %1, %2\n\tv_exp_f32 %0, %0" : "=v"(d) : "v"(a), "v"(b)); return d; }
__device__ __forceinline__ float fmax3_s(float a, float b, float c) { float d; asm volatile("v_max3_f32 %0, %1, %2, %3" : "=v"(d) : "v"(a), "v"(b), "v"(c)); return d; }
__device__ __forceinline__ float fadd_s(float a, float b) { float d; asm volatile("v_add_f32 %0, %1, %2" : "=v"(d) : "v"(a), "v"(b)); return d; }
__device__ __forceinline__ void mask_half(f32x16& p, int dq) {
    const float NEG = -__builtin_inff();
#pragma unroll
    for (int r = 0; r < 16; ++r) { const int c = (r & 3) + 8 * (r >> 2); if (dq - c < 0) p[r] = NEG; }
}
template <int KB> __device__ __forceinline__ void attn_tile(f32x16* o, const char* lds, const int (&kn)[4], const int (&kr)[2], const int (&vr)[2], const v8i32* qr8, float& m_reg, float& l_reg,
                                                             bool first, bool msk, int dq, int hi, int r32, float* al_l) {
    f32x16 p0, p1; v4i32 pa_lo, pa_hi; v8i32 f0, f1, f2, g0, g1, g2;
    int sk_ = 0x7a7a7a7a, sq_ = 0x77777777; asm volatile("" : "+v"(sk_), "+v"(sq_));
#define K_LD8N(F, s_, H) do { const v4i32 lo_ = *reinterpret_cast<const v4i32*>(lds + kn[2 * (s_)] + (OFF_KN + KB * SHM_KN + (H) * 4096)), hi2_ = *reinterpret_cast<const v4i32*>(lds + kn[2 * (s_) + 1] + (OFF_KN + KB * SHM_KN + (H) * 4096)); \
        F = __builtin_shufflevector(lo_, hi2_, 0, 1, 2, 3, 4, 5, 6, 7); } while (0)
#define K_LD8R(F, H) do { const v4i32 lo_ = *reinterpret_cast<const v4i32*>(lds + kr[0] + (OFF_KR + KB * SHM_KR + (H) * 2048)), hi2_ = *reinterpret_cast<const v4i32*>(lds + kr[1] + (OFF_KR + KB * SHM_KR + (H) * 2048)); \
        F = __builtin_shufflevector(lo_, hi2_, 0, 1, 2, 3, 4, 5, 6, 7); } while (0)
#define QK0(P, F, Q) asm volatile("v_mfma_scale_f32_32x32x64_f8f6f4 %0, %1, %2, 0, %3, %4 op_sel_hi:[0,0,0]" : "=&v"(P) : "v"(F), "v"(Q), "v"(sk_), "v"(sq_))
#define QKA(P, F, Q) asm volatile("v_mfma_scale_f32_32x32x64_f8f6f4 %0, %1, %2, %0, %3, %4 op_sel_hi:[0,0,0]" : "+v"(P) : "v"(F), "v"(Q), "v"(sk_), "v"(sq_))
    K_LD8N(f0, 0, 0); K_LD8N(f1, 1, 0); K_LD8R(f2, 0); SBAR(); __builtin_amdgcn_s_setprio(1);
    K_LD8N(g0, 0, 1); SBAR(); QK0(p0, f0, qr8[0]); SBAR();
    K_LD8N(g1, 1, 1); SBAR(); QKA(p0, f1, qr8[1]); SBAR();
    K_LD8R(g2, 1);    SBAR(); QKA(p0, f2, qr8[2]); SBAR();
    QK0(p1, g0, qr8[0]); asm volatile("s_nop 7" ::: "memory"); SBAR();
    __builtin_amdgcn_s_setprio(0);
    if (msk) mask_half(p0, dq);
    float m0 = fmax3_s(p0[0], p0[1], p0[2]);
#pragma unroll
    for (int r = 3; r < 15; r += 2) m0 = fmax3_s(m0, p0[r], p0[r + 1]);
    m0 = fmax3_s(m0, p0[15], p0[15]);
    float psa = 0.f, psb = 0.f; const float mcur = m_reg; const float mc6 = mcur - 6.f;
#define PK8(P, OUT) do { _Pragma("unroll") for (int w_ = 0; w_ < 4; ++w_) { int x_; \
        asm volatile("v_cvt_pk_fp8_f32 %0, %1, %2\n\tv_cvt_pk_fp8_f32 %0, %3, %4 op_sel:[0,0,1]" : "=&v"(x_) : "v"(P[4 * w_]), "v"(P[4 * w_ + 1]), "v"(P[4 * w_ + 2]), "v"(P[4 * w_ + 3])); OUT[w_] = x_; } } while (0)
#define EXP0(r_) do { p0[r_] = fexp2sub_s(p0[r_], mc6); p0[r_ + 1] = fexp2sub_s(p0[r_ + 1], mc6); psa = fadd_s(psa, p0[r_]); psb = fadd_s(psb, p0[r_ + 1]); } while (0)
#define EXP1(r_) do { p1[r_] = fexp2sub_s(p1[r_], mn6); p1[r_ + 1] = fexp2sub_s(p1[r_ + 1], mn6); psa = fadd_s(psa, p1[r_]); psb = fadd_s(psb, p1[r_ + 1]); } while (0)
    EXP0(0); EXP0(2); EXP0(4); SBAR();
    QKA(p1, g1, qr8[1]); SBAR(); EXP0(6); EXP0(8); EXP0(10); SBAR();
    QKA(p1, g2, qr8[2]); SBAR(); EXP0(12); EXP0(14); PK8(p0, pa_lo);
    asm volatile("s_nop 15\n\ts_nop 15\n\ts_nop 15" ::: "memory"); SBAR();
    if (msk) mask_half(p1, dq - 32);
    float pmax = fmax3_s(p1[0], p1[1], m0);
#pragma unroll
    for (int r = 2; r < 16; r += 2) pmax = fmax3_s(pmax, p1[r], p1[r + 1]);
    { auto rr = __builtin_amdgcn_permlane32_swap(__float_as_uint(pmax), __float_as_uint(pmax), false, false); pmax = fmaxf(__uint_as_float(rr[0]), __uint_as_float(rr[1])); }
    float alpha = 1.f;
    if (__builtin_expect(first || !__all(pmax - mcur <= 2.f), 0)) {
        const float dl = first ? pmax - mcur : fmaxf(pmax - mcur, 0.f); const float f = __builtin_amdgcn_exp2f(-dl);
        alpha = first ? 0.f : f; m_reg = mcur + dl; psa = fminf(psa, 3.0e38f) * f; psb = fminf(psb, 3.0e38f) * f;
#pragma unroll
        for (int r = 0; r < 16; ++r) p0[r] = fminf(p0[r], 3.0e38f) * f;
        PK8(p0, pa_lo);
        if (hi == 0) al_l[r32] = alpha; asm volatile("s_waitcnt lgkmcnt(0)" ::: "memory");
#pragma unroll
        for (int d_ = 0; d_ < 4; ++d_)
#pragma unroll
            for (int r = 0; r < 16; ++r) o[d_][r] *= al_l[crow(r, hi)];
    }
    const float mn6 = m_reg - 6.f;
    EXP1(0); EXP1(2); EXP1(4); EXP1(6); EXP1(8); EXP1(10); EXP1(12); EXP1(14);
    PK8(p1, pa_hi);
    const v8i32 pa8 = __builtin_shufflevector(pa_lo, pa_hi, 0, 1, 2, 3, 4, 5, 6, 7);
    int sp_ = 0x79797979, sv_ = 0x7a7a7a7a; asm volatile("" : "+v"(sp_), "+v"(sv_));
#define V_LD8(F, d0) do { const v4i32 lo_ = *reinterpret_cast<const v4i32*>(lds + vr[0] + (OFF_V + KB * SHM_V + (d0) * 2048)), hi2_ = *reinterpret_cast<const v4i32*>(lds + vr[1] + (OFF_V + KB * SHM_V + (d0) * 2048)); \
        F = __builtin_shufflevector(lo_, hi2_, 0, 1, 2, 3, 4, 5, 6, 7); } while (0)
#define PVM(d0, F) asm volatile("v_mfma_scale_f32_32x32x64_f8f6f4 %0, %1, %2, %0, %3, %4 op_sel_hi:[0,0,0]" : "+v"(o[d0]) : "v"(pa8), "v"(F), "v"(sp_), "v"(sv_))
    V_LD8(f0, 0); V_LD8(f1, 1); SBAR(); __builtin_amdgcn_s_setprio(1);
    V_LD8(f2, 2); SBAR(); PVM(0, f0); SBAR();
    V_LD8(g0, 3); SBAR(); PVM(1, f1); SBAR();
    PVM(2, f2); SBAR(); PVM(3, g0); SBAR();
    __builtin_amdgcn_s_setprio(0);
    float ps = psa + psb;
    { auto rr = __builtin_amdgcn_permlane32_swap(__float_as_uint(ps), __float_as_uint(ps), false, false); ps = __uint_as_float(rr[0]) + __uint_as_float(rr[1]); }
    l_reg = l_reg * alpha + ps * (1.f / 64.f);
#undef K_LD8N
#undef K_LD8R
#undef QK0
#undef QKA
#undef EXP0
#undef EXP1
#undef PK8
#undef V_LD8
#undef PVM
}
__device__ __forceinline__ void attn_unit(int b, int h, int qb, const bf16_t* Qm, const bf16_t* KVm, const bf16_t* KRm, bf16_t* Om, char* lds) {
    const int tid = threadIdx.x, wid = __builtin_amdgcn_readfirstlane(tid >> 6), lane = tid & 63, r32 = lane & 31, hi = lane >> 5;
    const size_t rowbase = (size_t)b * SEQ; const int q0 = qb * 256;
    v8i32 qr8[3];
    { const unsigned char* Qw = (const unsigned char*)Qm + (rowbase + q0 + wid * 32 + r32) * NQ + h * QKD + hi * 32;
#pragma unroll
      for (int s_ = 0; s_ < 3; ++s_) { const v4i32 lo_ = *reinterpret_cast<const v4i32*>(Qw + s_ * 64), hi2_ = *reinterpret_cast<const v4i32*>(Qw + s_ * 64 + 16); qr8[s_] = __builtin_shufflevector(lo_, hi2_, 0, 1, 2, 3, 4, 5, 6, 7); } }
    const int NT = (q0 + 256) / KVBLK;
    const int qlo = q0 + wid * 32, qm = qlo + r32 - 4 * hi;
    float* wsf = (float*)(lds + OFF_WS) + wid * 64; float* li_l = wsf; float* al_l = wsf + 32;
    float m_reg = 0.f, l_reg = 0.f; f32x16 o[4] = {};
    int kn[4], kr[2];
#pragma unroll
    for (int q_ = 0; q_ < 4; ++q_) kn[q_] = KSWZ8(r32, 4 * (q_ >> 1) + 2 * hi + (q_ & 1));
    kr[0] = KRSWZ8(r32, 2 * hi); kr[1] = KRSWZ8(r32, 2 * hi + 1);
    int vr[2]; vr[0] = VSWZ8(r32, 2 * hi); vr[1] = VSWZ8(r32, 2 * hi + 1);
    const unsigned char* Kb8 = (const unsigned char*)KVm + rowbase * 1536 + h * 128;
    const unsigned char* Vt8 = (const unsigned char*)KVm + 48 * MiB + ((size_t)(b * NH + h) * (SEQ / KVBLK)) * 8192;
    const unsigned char* Rb8 = (const unsigned char*)KRm + rowbase * 64;
    u32x4 st_kn, st_kr, st_v;
#define SLOAD(t) do { int t_ = tid; asm volatile("" : "+v"(t_)); const unsigned tr_ = (unsigned)t_ & 255u; \
        st_v = *reinterpret_cast<const u32x4*>(Vt8 + (size_t)(t) * 8192 + (unsigned)t_ * 16u); \
        st_kn = *reinterpret_cast<const u32x4*>(Kb8 + (size_t)(t) * (KVBLK * 1536) + ((unsigned)t_ >> 3) * 1536u + ((unsigned)t_ & 7u) * 16u); \
        st_kr = *reinterpret_cast<const u32x4*>(Rb8 + (size_t)(t) * (KVBLK * 64) + tr_ * 16u); } while (0)
#define SWRITE(bf) do { int t_ = tid; asm volatile("" : "+v"(t_)); const int tr_ = t_ & 255; \
        *(u32x4*)(lds + OFF_V + (bf) * SHM_V + VSWZ8(t_ >> 2, t_ & 3)) = st_v; \
        *(u32x4*)(lds + OFF_KN + (bf) * SHM_KN + KSWZ8(t_ >> 3, t_ & 7)) = st_kn; \
        *(u32x4*)(lds + OFF_KR + (bf) * SHM_KR + KRSWZ8(tr_ >> 2, tr_ & 3)) = st_kr; } while (0)
#define VMW() asm volatile("s_waitcnt vmcnt(0)" ::: "memory")
#define STEP(t, KB, NB) do { const int kb_ = (t) * KVBLK; SBAR(); \
        attn_tile<KB>(o, lds, kn, kr, vr, qr8, m_reg, l_reg, (t) == 0, kb_ + KVBLK - 1 > qlo, qm - kb_, hi, r32, al_l); \
        if ((t) + 1 < NT) { VMW(); SWRITE(NB); SBAR(); if ((t) + 2 < NT) SLOAD((t) + 2); } \
        __syncthreads(); } while (0)
    SLOAD(0); VMW(); SWRITE(0); SBAR(); SLOAD(1);
    __syncthreads();
    for (int t = 0; t < NT; t += 2) { STEP(t, 0, 1); STEP(t + 1, 1, 0); }
    if (hi == 0) li_l[r32] = l_reg; asm volatile("s_waitcnt lgkmcnt(0)" ::: "memory");
    int hi_e = hi; asm volatile("" : "+v"(hi_e));
    unsigned char* Ow = (unsigned char*)Om + (rowbase + q0 + wid * 32) * 2560 + 1024 + h * 128 + (size_t)(4 * hi_e) * 2560 + r32;
#pragma unroll
    for (int r = 0; r < 16; ++r) { const int orow = (r & 3) + 8 * (r >> 2); const float rl = 32.f * __builtin_amdgcn_rcpf(li_l[orow + 4 * hi_e]);
#pragma unroll
        for (int d0 = 0; d0 < 4; ++d0) { const float v = o[d0][r] * rl; const float v1 = __shfl_down(v, 1), v2 = __shfl_down(v, 2), v3 = __shfl_down(v, 3);
            if ((r32 & 3) == 0) { int w = __builtin_amdgcn_cvt_pk_fp8_f32(v, v1, 0, false); w = __builtin_amdgcn_cvt_pk_fp8_f32(v2, v3, w, true); *(unsigned*)(Ow + orow * 2560 + d0 * 32) = (unsigned)w; } } }
    __syncthreads();
#undef SLOAD
#undef SWRITE
#undef VMW
#undef STEP
}
#undef KSWZ8
#undef KRSWZ8
#undef VSWZ8
#undef SBAR
}


#define XB_TMO      128
#define XB_XCNT(j)  (256  + 64 * (j))
#define XB_XSUB(j)  (1280 + 64 * (j))
#define XB_XGEN(j)  (2304 + 64 * (j))
#define XB_TOP      3328
#define XB_TOPGEN   3392
#define XCD_BAR_WORDS 3456
#define XB_SPIN_CAP (1u << 18)
__device__ __forceinline__ unsigned xb_ld(unsigned* p)              { return __hip_atomic_load(p, __ATOMIC_RELAXED, __HIP_MEMORY_SCOPE_AGENT); }
__device__ __forceinline__ unsigned xb_add(unsigned* p, unsigned v) { return __hip_atomic_fetch_add(p, v, __ATOMIC_RELAXED, __HIP_MEMORY_SCOPE_AGENT); }
__device__ __forceinline__ unsigned xb_xcc_id() { return (unsigned)__builtin_amdgcn_s_getreg((3 << 11) | 20) & 0xFu; }
#define XB_SPIN(cond, bar) do { unsigned _sp = 0; while (cond) { __builtin_amdgcn_s_sleep(1); \
    if ((++_sp & 255u) == 0u) { if (xb_ld(&(bar)[XB_TMO])) break; if (_sp > XB_SPIN_CAP) { atomicAdd(&(bar)[XB_TMO], 1u); break; } } } } while (0)
struct XcdBarrier { unsigned* bar; unsigned x; volatile LAS unsigned* st; };
__device__ __forceinline__ XcdBarrier xcd_barrier_post(unsigned* bar, volatile LAS unsigned* st) {
    XcdBarrier b; b.bar = bar; b.x = xb_xcc_id(); b.st = st;
    if (threadIdx.x == 0) (void)xb_add(&bar[XB_XCNT(b.x)], 1u);
    return b;
}
__device__ __forceinline__ void xcd_barrier_complete(unsigned* bar, unsigned x, unsigned& nloc, unsigned& nx) {
    const unsigned G = gridDim.x * gridDim.y * gridDim.z;
    unsigned sum, cnt, mine, sp = 0u;
    for (;;) {
        sum = 0u; cnt = 0u; mine = 0u;
#pragma unroll
        for (unsigned j = 0; j < 16; ++j) { const unsigned c = xb_ld(&bar[XB_XCNT(j)]); sum += c; cnt += (c > 0u) ? 1u : 0u; mine = (j == x) ? c : mine; }
        if (sum == G) break;
        __builtin_amdgcn_s_sleep(1);
        if ((++sp & 255u) == 0u) { if (xb_ld(&bar[XB_TMO])) break; if (sp > XB_SPIN_CAP) { atomicAdd(&bar[XB_TMO], 1u); break; } }
    }
    nloc = mine > 0u ? mine : 1u; nx = cnt > 0u ? cnt : 1u;
}
__device__ __forceinline__ void xcd_barrier(const XcdBarrier& b) {
    asm volatile("s_waitcnt vmcnt(0)" ::: "memory");
    __syncthreads();
    if (threadIdx.x == 0) {
        unsigned* bar = b.bar;
        __builtin_amdgcn_s_waitcnt(0);
        unsigned nloc = b.st[0], nx = b.st[1];
        if (nloc == 0u) { xcd_barrier_complete(bar, b.x, nloc, nx); b.st[0] = nloc; b.st[1] = nx; }
        const unsigned old = xb_add(&bar[XB_XSUB(b.x)], 1u);
        const unsigned gen = old / nloc;
        if (old + 1u == (gen + 1u) * nloc) {
            __builtin_amdgcn_fence(__ATOMIC_RELEASE, "agent");
            asm volatile("s_waitcnt vmcnt(0)" ::: "memory");
            const unsigned og = xb_add(&bar[XB_TOP], 1u);
            const unsigned tg = og / nx;
            if (og + 1u == (tg + 1u) * nx) xb_add(&bar[XB_TOPGEN], 1u);
            else XB_SPIN(xb_ld(&bar[XB_TOPGEN]) == tg, bar);
            __builtin_amdgcn_fence(__ATOMIC_ACQUIRE, "agent");
            xb_add(&bar[XB_XGEN(b.x)], 1u);
            asm volatile("s_waitcnt vmcnt(0)" ::: "memory");
        } else {
            XB_SPIN(xb_ld(&bar[XB_XGEN(b.x)]) == gen, bar);
            __builtin_amdgcn_fence(__ATOMIC_ACQUIRE, "agent");
            asm volatile("s_waitcnt vmcnt(0)" ::: "memory");
        }
    }
    __syncthreads();
}

struct Args {
    const float *x, *p; const int* positions; const float *mix_g, *w_in, *pool_w, *pool_scale, *q_g, *w_uq, *kv_g, *w_ukv, *w_o, *ffn_g, *peer_wq, *sub_keys, *peer_u, *peer_v, *ple_g, *ple_wg, *ple_wp, *final_g;
    float* out; unsigned char* ws; int ph_lo, ph_hi;
};

template <class Map> __device__ __forceinline__ void transpose_item(const float* W, int ldw, const float* kscale, bf16_t* WT, int ldt, LAS float* scr, int k0, int n0, int lane, Map map) {
    const int ns = map(n0 + (lane & 31));
#pragma unroll
    for (int i = 0; i < 32; ++i) { const int kk = 2 * i + (lane >> 5); float v = ns >= 0 ? W[(size_t)(k0 + kk) * ldw + ns] : 0.f; if (kscale) v *= kscale[k0 + kk]; scr[kk * 33 + (lane & 31)] = v; }
    LDS_WAIT(); asm volatile("" ::: "memory");
    const int c = lane & 7;
#pragma unroll
    for (int j = 0; j < 4; ++j) { const int n = (lane >> 3) + 8 * j; const LAS float* s = scr + (8 * c) * 33 + n;
        u32x4 o; o.x = cvt_pk_bf16(s[0 * 33], s[1 * 33]); o.y = cvt_pk_bf16(s[2 * 33], s[3 * 33]); o.z = cvt_pk_bf16(s[4 * 33], s[5 * 33]); o.w = cvt_pk_bf16(s[6 * 33], s[7 * 33]);
        *(u32x4*)(WT + (size_t)(n0 + n) * ldt + k0 + 8 * c) = o; }
    LDS_WAIT(); asm volatile("" ::: "memory");
}
template <class Map> __device__ __forceinline__ void transpose_item_fp8(const float* W, int ldw, const float* kscale, float wscale, unsigned char* WT, int ldt, LAS float* scr, int k0, int n0, int lane, Map map) {
    const int ns = map(n0 + (lane & 31));
#pragma unroll
    for (int i = 0; i < 32; ++i) { const int kk = 2 * i + (lane >> 5); scr[kk * 33 + (lane & 31)] = W[(size_t)(k0 + kk) * ldw + ns] * (kscale ? kscale[k0 + kk] : 1.f) * wscale; }
    LDS_WAIT(); asm volatile("" ::: "memory");
    const int c = lane & 7;
#pragma unroll
    for (int j = 0; j < 4; ++j) { const int n = (lane >> 3) + 8 * j; const LAS float* sp = scr + (8 * c) * 33 + n;
        int w0 = __builtin_amdgcn_cvt_pk_fp8_f32(sp[0 * 33], sp[1 * 33], 0, false); w0 = __builtin_amdgcn_cvt_pk_fp8_f32(sp[2 * 33], sp[3 * 33], w0, true);
        int w1 = __builtin_amdgcn_cvt_pk_fp8_f32(sp[4 * 33], sp[5 * 33], 0, false); w1 = __builtin_amdgcn_cvt_pk_fp8_f32(sp[6 * 33], sp[7 * 33], w1, true);
        *(u32x2*)(WT + (size_t)(n0 + n) * ldt + k0 + 8 * c) = (u32x2){(unsigned)w0, (unsigned)w1}; }
    LDS_WAIT(); asm volatile("" ::: "memory");
}
__device__ __forceinline__ int rope_perm(int j) { return (j & 1) ? 32 + (j >> 1) : (j >> 1); }

__device__ __forceinline__ void p0_prologue(const Args& a, LAS unsigned char* lds, int vcu, int G, int tid, int lane, int wave) {
    unsigned char* ws = a.ws;
    const int gw = vcu * NWAVES + wave, NGW = G * NWAVES;
    const int gt = vcu * NTHR + tid, NGT = G * NTHR;
    { u64* st = (u64*)(ws + WS_CTL); for (int i = gt; i < 5 * T; i += NGT) st[i] = 0ull; }
    { bf16_t* XN = (bf16_t*)(ws + WS_AB); float* RMS = (float*)(ws + WS_CTL + 5 * (size_t)T * 8 + 4096);
      for (int r = gw; r < T; r += NGW) { const f32x4* xr = (const f32x4*)(a.x + (size_t)r * D) + lane; f32x4 v[8]; float s = 0.f;
#pragma unroll
          for (int j = 0; j < 8; ++j) { v[j] = xr[64 * j]; s += (v[j][0] * v[j][0] + v[j][1] * v[j][1]) + (v[j][2] * v[j][2] + v[j][3] * v[j][3]); }
          const float q = wave_sum(s) * (1.f / D) + EPS, ri = rsqrtf(q); if (lane == 0) RMS[r] = q * ri;
          u32x2* o = (u32x2*)(XN + (size_t)r * D) + lane;
#pragma unroll
          for (int j = 0; j < 8; ++j) { u32x2 w; w.x = cvt_pk_bf16(v[j][0] * ri, v[j][1] * ri); w.y = cvt_pk_bf16(v[j][2] * ri, v[j][3] * ri); o[64 * j] = w; } } }
    { u32x2* PB = (u32x2*)(ws + WS_PB); const f32x4* ps = (const f32x4*)a.p;
      for (int i = gt; i < T * DPLE / 4; i += NGT) { const f32x4 v = ps[i]; u32x2 w; w.x = cvt_pk_bf16(v[0], v[1]); w.y = cvt_pk_bf16(v[2], v[3]); PB[i] = w; } }
    { float* RP = (float*)(ws + WS_ROPE);
      for (int i = gt; i < T * 32; i += NGT) { const int r = i >> 5, f = i & 31; const float invf = exp2f(-(float)f * (13.287712379549449f / 32.f));
          const float ang = (float)a.positions[r] * invf; float sn, cs; sincosf(ang, &sn, &cs); RP[(size_t)r * 64 + f] = cs; RP[(size_t)r * 64 + 32 + f] = sn; } }
    { LAS float* scr = (LAS float*)(lds + wave * 16384);
      constexpr int I_IN = 32 * 56, I_UQ = 8 * 72, I_UKV = 8 * 96, I_O = 24 * 64, I_Q = 32 * 64, I_G = 32 * 64, I_P = 4 * 64;
      constexpr int NIT = I_IN + I_UQ + I_UKV + I_O + I_Q + I_G + I_P;
      for (int it = gw; it < NIT; it += NGW) { int r = it;
          if (r < I_IN) { transpose_item(a.w_in, DIN, a.mix_g, (bf16_t*)(ws + WS_WIN), D, scr, (r / 56) * 64, (r % 56) * 32, lane,
                [](int n) { return n < 1536 ? n : (n < 1600 ? 1536 + rope_perm(n - 1536) : -1); }); continue; } r -= I_IN;
          if (r < I_UQ) { transpose_item_fp8(a.w_uq, NQ, a.q_g, 1024.f, (unsigned char*)(ws + WS_WUQ), 512, scr, (r / 72) * 64, (r % 72) * 32, lane,
                [](int n) { const int h = n / QKD, c = n % QKD; return c < 128 ? n : h * QKD + 128 + rope_perm(c - 128); }); continue; } r -= I_UQ;
          if (r < I_UKV) { transpose_item_fp8(a.w_ukv, NKV, a.kv_g, 1024.f, (unsigned char*)(ws + WS_WUKV), 512, scr, (r / 96) * 64, (r % 96) * 32, lane,
                [](int n) { return n < 1536 ? (n >> 7) * 256 + (n & 127) : ((n - 1536) >> 7) * 256 + 128 + (n & 127); }); continue; } r -= I_UKV;
          if (r < I_O) { transpose_item_fp8(a.w_o, D, nullptr, 1024.f, (unsigned char*)(ws + WS_WO) + 512, 2560, scr, 512 + (r / 64) * 64, (r % 64) * 32, lane, [](int n) { return n; }); continue; } r -= I_O;
          if (r < I_Q) { transpose_item(a.peer_wq, D, a.ffn_g, (bf16_t*)(ws + WS_WQ), D, scr, (r / 64) * 64, (r % 64) * 32, lane, [](int n) { return n; }); continue; } r -= I_Q;
          if (r < I_G) { transpose_item_fp8(a.ple_wg, D, a.ple_g, 1024.f, (unsigned char*)(ws + WS_WG), D, scr, (r / 64) * 64, (r % 64) * 32, lane, [](int n) { return n; }); continue; } r -= I_G;
          transpose_item(a.ple_wp, D, nullptr, (bf16_t*)(ws + WS_WP), DPLE, scr, (r / 64) * 64, (r % 64) * 32, lane, [](int n) { return n; });
      } }
    { bf16_t* WO = (bf16_t*)(ws + WS_WO);
      for (int i = gt; i < (DPOOL / 8) * D; i += NGT) { const int n = i & (D - 1), k0 = (i >> 11) * 8, g = k0 >> 7; float sacc[8];
#pragma unroll
          for (int c = 0; c < 8; ++c) sacc[c] = 0.f;
#pragma unroll 8
          for (int d = 0; d < 128; ++d) { const float wv = a.pool_scale[g * 128 + d] * a.w_o[(size_t)(g * 128 + d) * D + n];
#pragma unroll
              for (int c = 0; c < 8; ++c) sacc[c] += a.pool_w[(size_t)(k0 + c) * 128 + d] * wv; }
          u32x4 w; w.x = cvt_pk_bf16(sacc[0] * 1024.f, sacc[1] * 1024.f); w.y = cvt_pk_bf16(sacc[2] * 1024.f, sacc[3] * 1024.f); w.z = cvt_pk_bf16(sacc[4] * 1024.f, sacc[5] * 1024.f); w.w = cvt_pk_bf16(sacc[6] * 1024.f, sacc[7] * 1024.f);
          *(u32x4*)((unsigned char*)WO + (size_t)n * 2560 + k0 * 2) = w; } }
    { bf16_t* SK = (bf16_t*)(ws + WS_SK);
      for (int i = gt; i < PH * 256 * 256; i += NGT) { const int c = i & 255, r = (i >> 8) & 255, h = i >> 16, pp = r >> 7;
          const float v = ((c >> 7) == pp) ? a.sub_keys[((size_t)(h * 2 + pp) * 128 + (r & 127)) * 128 + (c & 127)] : 0.f; SK[i] = (bf16_t)(cvt_pk_bf16(v, 0.f) & 0xffffu); } }
    { unsigned short* UT = (unsigned short*)(ws + WS_UT); unsigned short* VT = (unsigned short*)(ws + WS_VT); float* SU = (float*)(ws + WS_SU); float* SV = (float*)(ws + WS_SV);
      const int gw = vcu * NWAVES + wave, NGW = G * NWAVES;
#pragma unroll 1
      for (int e = gw; e < NEXP; e += NGW) { const f32x4* ur = (const f32x4*)a.peer_u + (size_t)e * (D / 4) + lane; const f32x4* vr = (const f32x4*)a.peer_v + (size_t)e * (D / 4) + lane;
          f32x4 u[8], v[8];
#pragma unroll
          for (int k = 0; k < 8; ++k) { u[k] = ur[64 * k]; v[k] = vr[64 * k]; }
          float mu = 0.f, mv = 0.f;
#pragma unroll
          for (int k = 0; k < 8; ++k) { mu = fmaxf(mu, fmaxf(fmaxf(fabsf(u[k][0]), fabsf(u[k][1])), fmaxf(fabsf(u[k][2]), fabsf(u[k][3])))); mv = fmaxf(mv, fmaxf(fmaxf(fabsf(v[k][0]), fabsf(v[k][1])), fmaxf(fabsf(v[k][2]), fabsf(v[k][3])))); }
#pragma unroll
          for (int o_ = 32; o_ >= 1; o_ >>= 1) { mu = fmaxf(mu, __shfl_xor(mu, o_)); mv = fmaxf(mv, __shfl_xor(mv, o_)); }
          mu = fmaxf(mu, 1e-30f); mv = fmaxf(mv, 1e-30f); const float su = 6.f / mu, sv = 6.f / mv;
          if (lane == 0) { SU[e] = mu * (1.f / 6.f); SV[e] = mv * (1.f / 6.f); }
#pragma unroll
          for (int k = 0; k < 8; ++k) { const size_t o = ((size_t)k * NEXP + e) * 64 + lane;
              unsigned p4 = __builtin_amdgcn_cvt_scalef32_pk_fp4_f32(0u, u[k][0] * su, u[k][1] * su, 1.0f, 0); p4 = __builtin_amdgcn_cvt_scalef32_pk_fp4_f32(p4, u[k][2] * su, u[k][3] * su, 1.0f, 1); UT[o] = (unsigned short)p4;
              p4 = __builtin_amdgcn_cvt_scalef32_pk_fp4_f32(0u, v[k][0] * sv, v[k][1] * sv, 1.0f, 0); p4 = __builtin_amdgcn_cvt_scalef32_pk_fp4_f32(p4, v[k][2] * sv, v[k][3] * sv, 1.0f, 1); VT[o] = (unsigned short)p4; } } }
}

__device__ __forceinline__ float dpp_xor1(float v) { return __builtin_bit_cast(float, __builtin_amdgcn_update_dpp(0, __builtin_bit_cast(int, v), 0xB1, 0xF, 0xF, true)); }
__device__ __forceinline__ float dpp_xor2(float v) { return __builtin_bit_cast(float, __builtin_amdgcn_update_dpp(0, __builtin_bit_cast(int, v), 0x4E, 0xF, 0xF, true)); }
__device__ __forceinline__ void slice_setup(int bx, int G, int wave, int& x, int& wv, int& nwv) { x = bx & 7; const int nlab = (G - x + 7) >> 3; wv = (bx >> 3) * NWAVES + wave; nwv = nlab * NWAVES; }
__device__ __forceinline__ void p7a_upass(const Args& a, int bx, int G, int lane, int wave, LAS unsigned char* lds) {
    int x, wv, nwv; slice_setup(bx, G, wave, x, wv, nwv);
    const int g = lane >> 3, j = lane & 7, r = lane & 15, c = lane >> 4, gsel = r >> 2;
    const char* UT = (const char*)(a.ws + WS_UT); const bf16_t* AB = (const bf16_t*)(a.ws + WS_AB); const unsigned short* EID = (const unsigned short*)(a.ws + WS_EID);
    bf16_t* PART = (bf16_t*)(a.ws + WS_Z); const u64* ssq_ffn = (const u64*)(a.ws + WS_CTL) + 2 * T;
    const int s = x;
    const unsigned goff = (unsigned)g * 32u, soff = (unsigned)(s * (NEXP * 128) + j * 16), xoff = (unsigned)(s * 512 + lane * 8);
    unsigned poff = (unsigned)(16 * gsel + 4 * c) * 2u;
    LAS unsigned char* tile = lds + wave * 16896;
    LAS unsigned char* xim = tile + 16384;
    LAS unsigned char* wr_ = tile + g * 2048;
    const unsigned j16 = (unsigned)j * 16u;
    const LAS unsigned char* ra0 = tile + r * 128 + ((c ^ (r & 7)) * 16);
    const LAS unsigned char* ra1 = tile + r * 128 + (((c ^ (r & 7)) * 16) ^ 64);
    const LAS unsigned char* xr = xim + (r & 3) * 128 + c * 16;
    const float fac = (1.f / 0.75f) * ((r & 2) ? ((r & 1) ? (1.f / 256.f) : (1.f / 32.f)) : ((r & 1) ? 0.25f : 1.f));
    const f32x4 g4 = *(const f32x4*)(a.ffn_g + 256 * s + 4 * lane) * 0.75f;
    int one_e8m0 = 0x7f7f7f7f; asm volatile("" : "+v"(one_e8m0));
    int zero_v = 0; asm volatile("" : "+v"(zero_v));
#define U_TOK(n) __builtin_amdgcn_readfirstlane(wv + ((n) < cnt ? (n) : 0) * nwv)
#define U_IDX(EV, n) do { const char* eb_ = (const char*)EID + (size_t)U_TOK(n) * 256; _Pragma("unroll") for (int q = 0; q < 2; ++q) EV[q] = *(const u32x4*)(eb_ + (goff + q * 16)); } while (0)
#define EXP_ID(EV, i) ((EV[(i) >> 3][((i) >> 1) & 3] >> (((i) & 1) * 16)) & 0xffffu)
#define U_GATHER(W, X, SQ, EV, n) do { const int tk_ = U_TOK(n); \
        _Pragma("unroll") for (int i = 0; i < 16; ++i) W[i] = *(const u32x4*)(UT + (EXP_ID(EV, i) * 128u + soff)); \
        X = *(const u32x2*)((const char*)AB + (size_t)tk_ * (D * 2) + xoff); SQ = *(const u64*)((const char*)ssq_ffn + (size_t)tk_ * 8 + (unsigned)zero_v); } while (0)
#define U_MMA0(ACC, A_, B_) asm volatile("v_mfma_f32_16x16x128_f8f6f4 %0, %1, %2, 0 cbsz:4 blgp:4" : "=&v"(ACC) : "v"(A_), "v"(B_))
#define U_MMA1(ACC, A_, B_) asm volatile("v_mfma_f32_16x16x128_f8f6f4 %0, %1, %2, %0 cbsz:4 blgp:4" : "+v"(ACC) : "v"(A_), "v"(B_))
#define U_PK4(V) ({ unsigned p_ = __builtin_amdgcn_cvt_scalef32_pk_fp4_f32(0u, V[0], V[1], 1.0f, 0); __builtin_amdgcn_cvt_scalef32_pk_fp4_f32(p_, V[2], V[3], 1.0f, 1); })
#define U_UP4(P) ({ const f32x2 a_ = __builtin_amdgcn_cvt_scalef32_pk_f32_fp4(P, 1.0f, 0), b_ = __builtin_amdgcn_cvt_scalef32_pk_f32_fp4(P, 1.0f, 1); (f32x4){a_[0], a_[1], b_[0], b_[1]}; })
#define U_COMPUTE(W, X, SQ, O, O2, n) do { const int t = U_TOK(n); \
        const float ri = rsqrtf((float)SQ * (1.f / 1048576.f) * (1.f / D) + EPS); \
          \
        const f32x4 xv = (f32x4){bf_lo(X.x), bf_hi(X.x), bf_lo(X.y), bf_hi(X.y)} * ri * g4; \
        const unsigned t0_ = U_PK4(xv); const f32x4 r1_ = (xv - U_UP4(t0_)) * 4.f; \
        const unsigned t1_ = U_PK4(r1_); const f32x4 r2_ = (r1_ - U_UP4(t1_)) * 8.f; \
        const unsigned t2_ = U_PK4(r2_); const f32x4 r3_ = (r2_ - U_UP4(t2_)) * 8.f; \
        const unsigned t3_ = U_PK4(r3_); \
        *(LAS unsigned short*)(xim + 2 * lane) = (unsigned short)t0_; *(LAS unsigned short*)(xim + 128 + 2 * lane) = (unsigned short)t1_; \
        *(LAS unsigned short*)(xim + 256 + 2 * lane) = (unsigned short)t2_; *(LAS unsigned short*)(xim + 384 + 2 * lane) = (unsigned short)t3_; \
        _Pragma("unroll") for (int i = 0; i < 16; ++i) *(LAS u32x4*)(wr_ + i * 128 + (j16 ^ (unsigned)((i & 7) * 16))) = W[i]; \
        asm volatile("s_waitcnt lgkmcnt(0)" ::: "memory"); \
        const v4i32 B0 = *(const LAS v4i32*)(xr), B1 = *(const LAS v4i32*)(xr + 64); \
        f32x4 sc[8]; \
          \
        { v4i32 af_[16];                                          \
          _Pragma("unroll") for (int gg = 0; gg < 8; ++gg) { af_[gg] = *(const LAS v4i32*)(ra0 + gg * 2048); af_[8 + gg] = *(const LAS v4i32*)(ra1 + gg * 2048); } \
          __builtin_amdgcn_sched_barrier(0); \
          _Pragma("unroll") for (int gg = 0; gg < 8; ++gg) U_MMA0(sc[gg], af_[gg], B0); \
          _Pragma("unroll") for (int gg = 0; gg < 8; ++gg) U_MMA1(sc[gg], af_[8 + gg], B1); } \
        asm volatile("s_nop 15\n\ts_nop 7" : "+v"(sc[0]), "+v"(sc[1]), "+v"(sc[2]), "+v"(sc[3]), "+v"(sc[4]), "+v"(sc[5]), "+v"(sc[6]), "+v"(sc[7]));     \
          \
        f32x4 kA = sc[0], kB = sc[4]; \
        _Pragma("unroll") for (int gg = 1; gg < 4; ++gg) { const bool m_ = (gsel == gg); _Pragma("unroll") for (int q = 0; q < 4; ++q) { kA[q] = m_ ? sc[gg][q] : kA[q]; kB[q] = m_ ? sc[4 + gg][q] : kB[q]; } } \
        float vA[4], vB[4]; _Pragma("unroll") for (int q = 0; q < 4; ++q) { float pa_ = kA[q] * fac, pb_ = kB[q] * fac; pa_ += dpp_xor1(pa_); pb_ += dpp_xor1(pb_); vA[q] = pa_ + dpp_xor2(pa_); vB[q] = pb_ + dpp_xor2(pb_); } \
        asm volatile("" : "+v"(O), "+v"(O2), "+v"(poff));          \
        O = (u32x2){cvt_pk_bf16(vA[0], vA[1]), cvt_pk_bf16(vA[2], vA[3])}; O2 = (u32x2){cvt_pk_bf16(vB[0], vB[1]), cvt_pk_bf16(vB[2], vB[3])}; \
        if ((r & 3) == 0) { char* pp_ = (char*)PART + ((size_t)s * T + t) * 256; *(u32x2*)(pp_ + poff) = O; *(u32x2*)(pp_ + (poff + 128u)) = O2; } } while (0)
#define U_STEP(Wc, Xc, SQc, Oc, O2c, Wn, Xn, SQn, EVn, EVnn, n) do { \
        U_IDX(EVnn, (n) + 2); __builtin_amdgcn_sched_barrier(0); \
        U_GATHER(Wn, Xn, SQn, EVn, (n) + 1); __builtin_amdgcn_sched_barrier(0); \
        U_COMPUTE(Wc, Xc, SQc, Oc, O2c, n); __builtin_amdgcn_sched_barrier(0); } while (0)
    const int cnt = (T - wv + nwv - 1) / nwv;
    u32x4 wA[16], wB[16], evA[2], evB[2]; u32x2 xA, xB, oA = {0u, 0u}, oB = {0u, 0u}, pA = {0u, 0u}, pB = {0u, 0u}; u64 sqA, sqB;
    U_IDX(evA, 0); U_IDX(evB, 1); __builtin_amdgcn_sched_barrier(0);
    U_GATHER(wA, xA, sqA, evA, 0); __builtin_amdgcn_sched_barrier(0);
#pragma unroll 1
    for (int n = 0; ; n += 2) {
        U_STEP(wA, xA, sqA, oA, pA, wB, xB, sqB, evB, evA, n);
        if (n + 1 >= cnt) break;
        U_STEP(wB, xB, sqB, oB, pB, wA, xA, sqA, evA, evB, n + 1);
        if (n + 2 >= cnt) break;
    }
#undef U_TOK
#undef EXP_ID
#undef U_IDX
#undef U_GATHER
#undef U_MMA0
#undef U_MMA1
#undef U_PK4
#undef U_UP4
#undef U_COMPUTE
#undef U_STEP
}
#define V_PKT(OLD, V, SEL) __builtin_amdgcn_cvt_scalef32_pk_fp4_f32(OLD, V, V, 1.0f, SEL)
#define V_TERMS(V0, WOUT) do { unsigned w_ = V_PKT(0u, V0, 0); const float r1_ = (V0 - __builtin_amdgcn_cvt_scalef32_pk_f32_fp4(w_, 1.0f, 0)[0]) * 4.f; \
        w_ = V_PKT(w_, r1_, 1); const float r2_ = (r1_ - __builtin_amdgcn_cvt_scalef32_pk_f32_fp4(w_, 1.0f, 1)[0]) * 8.f; \
        w_ = V_PKT(w_, r2_, 2); const float r3_ = (r2_ - __builtin_amdgcn_cvt_scalef32_pk_f32_fp4(w_, 1.0f, 2)[0]) * 8.f; \
          \
        unsigned o_ = __builtin_amdgcn_cvt_scalef32_pk_fp4_f32(0u, V0, r1_, 1.0f, 0); o_ = __builtin_amdgcn_cvt_scalef32_pk_fp4_f32(o_, r2_, r3_, 1.0f, 1); WOUT = o_; } while (0)
__device__ __forceinline__ void p7b_apass(const Args& a, int vcu, int G, int tid) {
    const bf16_t* PART = (const bf16_t*)(a.ws + WS_Z); const float* GATE = (const float*)(a.ws + WS_GATE); const int gt = vcu * NTHR + tid, NGT = G * NTHR;
    const unsigned* EID2 = (const unsigned*)(a.ws + WS_EID); const float* SU = (const float*)(a.ws + WS_SU); const float* SV = (const float*)(a.ws + WS_SV);
    unsigned char* AIMG = a.ws + WS_AMIX; float* ASC = (float*)(a.ws + WS_AMIX + 64 * MiB);
    const int l = tid & 63; const unsigned rowo = (unsigned)(16 * (l & 7) + (l >> 3)) * 8u;
    for (int i = gt; i < T * 64; i += NGT) { float h0 = 0.f, h1 = 0.f;
#pragma unroll
        for (int s = 0; s < 8; ++s) { const unsigned w = *(const unsigned*)(PART + (size_t)s * T * 128 + 2 * i); h0 += bf_lo(w); h1 += bf_hi(w); }
        const f32x2 gt2 = *(const f32x2*)(GATE + 2 * i); const unsigned ee = EID2[i];
        const float x0 = h0 * SU[ee & 0xffffu], x1 = h1 * SU[ee >> 16];
        const float t0 = tanhf(0.7978845608028654f * (x0 + 0.044715f * x0 * x0 * x0)), t1 = tanhf(0.7978845608028654f * (x1 + 0.044715f * x1 * x1 * x1));
        const float a0 = gt2[0] * 0.5f * x0 * (1.f + t0) * SV[ee & 0xffffu], a1 = gt2[1] * 0.5f * x1 * (1.f + t1) * SV[ee >> 16];
        float am = fmaxf(fabsf(a0), fabsf(a1));
#pragma unroll
        for (int o_ = 32; o_ >= 1; o_ >>= 1) am = fmaxf(am, __shfl_xor(am, o_));
        am = fmaxf(am, 1e-30f); const float sa = 4.f / am; unsigned w0, w1;
        { const float v0 = a0 * sa, v1 = a1 * sa; V_TERMS(v0, w0); V_TERMS(v1, w1); }
        const int t = i >> 6; unsigned char* ip = AIMG + (size_t)t * 1024 + rowo;
        *(u32x2*)ip = (u32x2){w0, 0u}; *(u32x2*)(ip + 64) = (u32x2){w1, 0u};
        if (l == 0) ASC[t] = am * 0.25f; }
}
#undef V_PKT
#undef V_TERMS
__device__ __forceinline__ void p7c_vpass(const Args& a, int bx, int G, int lane, int wave, LAS unsigned char* lds) {
    int x, wv, nwv; slice_setup(bx, G, wave, x, wv, nwv);
    const int g = lane >> 3, j = lane & 7, n = lane & 15, c = lane >> 4;
    const char* VT = (const char*)(a.ws + WS_VT); bf16_t* AB = (bf16_t*)(a.ws + WS_AB); const unsigned short* EID = (const unsigned short*)(a.ws + WS_EID); const unsigned char* AIMG = a.ws + WS_AMIX; const float* ASC = (const float*)(a.ws + WS_AMIX + 64 * MiB);
    float* ssqp = (float*)(a.ws + WS_GATE); unsigned char* H28 = (unsigned char*)(a.ws + WS_KV); const unsigned goff = (unsigned)g * 32u;
    const int s = x;
    const unsigned soff = (unsigned)(s * (NEXP * 128) + j * 16), hoff = (unsigned)(256 * s + 4 * lane), aoff = (unsigned)(32 * (lane & 3) + (lane >> 2));
    LAS unsigned char* tile = lds + wave * 18432;
    LAS unsigned char* aimg = tile + 16384; LAS float* outb = (LAS float*)(tile + 17408);
    LAS unsigned char* wr_ = tile + g * 128 + ((j ^ g) * 16);
    const LAS unsigned char* rb_ = tile + (32 * c + n) * 128;
    const unsigned sw16 = (unsigned)(n & 7) * 16u;
    const LAS unsigned char* ra_ = aimg + (32 * c + n) * 8;
    int one_e8m0 = 0x7f7f7f7f; asm volatile("" : "+v"(one_e8m0));
    int zero_v = 0; asm volatile("" : "+v"(zero_v));
#define V_TOK(n_) __builtin_amdgcn_readfirstlane(wv + ((n_) < cnt ? (n_) : 0) * nwv)
#define V_IDX(EV, n_) do { const char* eb_ = (const char*)EID + (size_t)V_TOK(n_) * 256; _Pragma("unroll") for (int q = 0; q < 2; ++q) EV[q] = *(const u32x4*)(eb_ + (goff + q * 16)); } while (0)
#define EXP_ID(EV, i) ((EV[(i) >> 3][((i) >> 1) & 3] >> (((i) & 1) * 16)) & 0xffffu)
#define V_GATHER(W, AVw, ASw, HV, EV, n_) do { const int tk_ = V_TOK(n_); \
        _Pragma("unroll") for (int i = 0; i < 16; ++i) W[i] = *(const u32x4*)(VT + (EXP_ID(EV, i) * 128u + soff)); \
        AVw = *(const u32x4*)(AIMG + (size_t)tk_ * 1024 + lane * 16); ASw = *(const float*)((const char*)ASC + (size_t)tk_ * 4 + (unsigned)zero_v); \
        HV = *(const u32x2*)((const char*)AB + (size_t)tk_ * (D * 2) + hoff * 2u); } while (0)
#define V_TR(P) __builtin_amdgcn_ds_read_tr4_b64_v2i32((LAS v2i32*)(P))
#define V_MMA(ACC, A_, B_) asm volatile("v_mfma_f32_16x16x128_f8f6f4 %0, %1, %2, 0 cbsz:4 blgp:4" : "=&v"(ACC) : "v"(A_), "v"(B_))
#define V_BATCH(mb0) do { f32x4 dd[8]; v2i32 bl_[8], bh_[8]; \
          \
        _Pragma("unroll") for (int u = 0; u < 8; ++u) { const int mb = (mb0) + u; const LAS unsigned char* p_ = rb_ + (((unsigned)((mb >> 1) * 16)) ^ sw16) + (mb & 1) * 8; bl_[u] = V_TR(p_); bh_[u] = V_TR(p_ + 2048); } \
        __builtin_amdgcn_sched_barrier(0); \
        _Pragma("unroll") for (int u = 0; u < 8; ++u) { const v4i32 B_ = __builtin_shufflevector(bl_[u], bh_[u], 0, 1, 2, 3); V_MMA(dd[u], A_, B_); } \
        asm volatile("s_nop 15\n\ts_nop 7" : "+v"(dd[0]), "+v"(dd[1]), "+v"(dd[2]), "+v"(dd[3]), "+v"(dd[4]), "+v"(dd[5]), "+v"(dd[6]), "+v"(dd[7])); \
        if (c == 0) { _Pragma("unroll") for (int u = 0; u < 8; ++u) outb[16 * ((mb0) + u) + n] = (dd[u][0] + dd[u][1] * 0.25f) + (dd[u][2] * (1.f / 32.f) + dd[u][3] * (1.f / 256.f)); }     \
        __builtin_amdgcn_sched_barrier(0); } while (0)
#define V_COMPUTE(W, AVw, ASw, HV, n_) do { const int t = V_TOK(n_); \
        *(LAS u32x4*)(aimg + lane * 16) = AVw;                     \
        _Pragma("unroll") for (int i = 0; i < 16; ++i) *(LAS u32x4*)(wr_ + i * 1024) = W[i]; \
        asm volatile("s_waitcnt lgkmcnt(0)" ::: "memory"); \
        const v2i32 al_ = V_TR(ra_), ah_ = V_TR(ra_ + 128); const v4i32 A_ = __builtin_shufflevector(al_, ah_, 0, 1, 2, 3); \
        V_BATCH(0); V_BATCH(8); \
        asm volatile("s_waitcnt lgkmcnt(0)" ::: "memory"); \
        const f32x4 acc4 = *(const LAS f32x4*)(outb + 4 * lane) * ASw; \
        const f32x4 h2 = (f32x4){bf_lo(HV.x), bf_hi(HV.x), bf_lo(HV.y), bf_hi(HV.y)} + acc4; \
        *(u32x2*)((char*)AB + (size_t)t * (D * 2) + hoff * 2u) = (u32x2){cvt_pk_bf16(h2[0], h2[1]), cvt_pk_bf16(h2[2], h2[3])}; \
        { int w8_ = __builtin_amdgcn_cvt_pk_fp8_f32(h2[0] * 32.f, h2[1] * 32.f, 0, false); w8_ = __builtin_amdgcn_cvt_pk_fp8_f32(h2[2] * 32.f, h2[3] * 32.f, w8_, true); *(unsigned*)(H28 + (size_t)t * D + hoff) = (unsigned)w8_; } \
        const float ss = wave_sum_dpp((h2[0] * h2[0] + h2[1] * h2[1]) + (h2[2] * h2[2] + h2[3] * h2[3])); if (lane == 0) ssqp[(size_t)s * T + t] = ss; } while (0)
#define V_STEP(Wc, AVc, ASc, HVc, Wn, AVn, ASn, HVn, EVn, EVnn, n_) do { \
        V_IDX(EVnn, (n_) + 2); __builtin_amdgcn_sched_barrier(0); \
        V_GATHER(Wn, AVn, ASn, HVn, EVn, (n_) + 1); __builtin_amdgcn_sched_barrier(0); \
        V_COMPUTE(Wc, AVc, ASc, HVc, n_); __builtin_amdgcn_sched_barrier(0); } while (0)
    const int cnt = (T - wv + nwv - 1) / nwv;
    u32x4 wA[16], wB[16], evA[2], evB[2], avA, avB; float asA, asB; u32x2 hvA, hvB;
    V_IDX(evA, 0); V_IDX(evB, 1); __builtin_amdgcn_sched_barrier(0);
    V_GATHER(wA, avA, asA, hvA, evA, 0); __builtin_amdgcn_sched_barrier(0);
#pragma unroll 1
    for (int n_ = 0; n_ < cnt; n_ += 2) {
        V_STEP(wA, avA, asA, hvA, wB, avB, asB, hvB, evB, evA, n_);
        if (n_ + 1 < cnt) V_STEP(wB, avB, asB, hvB, wA, avA, asA, hvA, evA, evB, n_ + 1);
    }
#undef V_TOK
#undef EXP_ID
#undef V_IDX
#undef V_GATHER
#undef V_TR
#undef V_MMA
#undef V_BATCH
#undef V_COMPUTE
#undef V_STEP
}
__device__ __forceinline__ void p8_final(const Args& a, int vcu, int G, int lane, int wave, float oscale) {
    const int gw = vcu * NWAVES + wave, NGW = G * NWAVES; const u64* ssq = (const u64*)(a.ws + WS_CTL) + 3 * T; const bf16_t* H3 = (const bf16_t*)(a.ws + WS_AMIX);
    f32x4 gv[8];
#pragma unroll
    for (int j = 0; j < 8; ++j) gv[j] = ((const f32x4*)a.final_g)[64 * j + lane];
    for (int r = gw; r < T; r += NGW) { f32x4* orow = (f32x4*)(a.out + (size_t)r * D) + lane; const u32x2* hr = (const u32x2*)(H3 + (size_t)r * D) + lane; const float ri = rsqrtf(ssq_get(ssq + r) * (1.f / D) + EPS) * oscale;
        u32x2 hw[8];
#pragma unroll
        for (int j = 0; j < 8; ++j) hw[j] = hr[64 * j];
#pragma unroll
        for (int j = 0; j < 8; ++j) { f32x4 v = {bf_lo(hw[j].x), bf_hi(hw[j].x), bf_lo(hw[j].y), bf_hi(hw[j].y)}; v = v * ri * gv[j]; orow[64 * j] = v; } }
}

__device__ __forceinline__ void p2_pool_kr(const Args& a, int vcu, int G, int lane, int wave) {
    const int gw = vcu * NWAVES + wave, NGW = G * NWAVES; const bf16_t* Z = (const bf16_t*)(a.ws + WS_Z); bf16_t* AM = (bf16_t*)(a.ws + WS_AMIX); bf16_t* KR = (bf16_t*)(a.ws + WS_KR);
    const float* RP = (const float*)(a.ws + WS_ROPE);
    const int grp = lane >> 4, w = 2 << grp;
#pragma unroll 1
    for (int run = gw; run < T / 16; run += NGW) { const int t0 = run * 16, s0 = t0 & (SEQ - 1);
        u32x4 rows[31];
#pragma unroll
        for (int i = 0; i < 31; ++i) { const int dt = i - 15; const int dc = (s0 + dt >= 0) ? dt : -s0;
            rows[i] = *(const u32x4*)(Z + (size_t)(t0 + dc) * DINP + 8 * lane); }
#pragma unroll
        for (int i = 0; i < 15; ++i) { if (s0 + i - 15 < 0) rows[i] = (u32x4){0u, 0u, 0u, 0u}; }
#pragma unroll
        for (int i = 0; i < 16; ++i) {
            float acc[8];
#define ADDROW(R) do { acc[0] += bf_lo(R.x); acc[1] += bf_hi(R.x); acc[2] += bf_lo(R.y); acc[3] += bf_hi(R.y); acc[4] += bf_lo(R.z); acc[5] += bf_hi(R.z); acc[6] += bf_lo(R.w); acc[7] += bf_hi(R.w); } while (0)
            const u32x4 z0 = rows[15 + i]; float x0[8];
            x0[0] = bf_lo(z0.x); x0[1] = bf_hi(z0.x); x0[2] = bf_lo(z0.y); x0[3] = bf_hi(z0.y); x0[4] = bf_lo(z0.z); x0[5] = bf_hi(z0.z); x0[6] = bf_lo(z0.w); x0[7] = bf_hi(z0.w);
#pragma unroll
            for (int e = 0; e < 8; ++e) acc[e] = x0[e];
            ADDROW(rows[14 + i]);
            if (grp >= 1) { ADDROW(rows[13 + i]); ADDROW(rows[12 + i]); }
            if (grp >= 2) { ADDROW(rows[11 + i]); ADDROW(rows[10 + i]); ADDROW(rows[9 + i]); ADDROW(rows[8 + i]); }
            if (grp >= 3) { ADDROW(rows[7 + i]); ADDROW(rows[6 + i]); ADDROW(rows[5 + i]); ADDROW(rows[4 + i]); ADDROW(rows[3 + i]); ADDROW(rows[2 + i]); ADDROW(rows[1 + i]); ADDROW(rows[i]); }
#undef ADDROW
            const int s = s0 + i; const int cnt = (s + 1 < w) ? s + 1 : w; const float ic = 32.f * __builtin_amdgcn_rcpf((float)cnt); u32x4 o;
            o.x = cvt_pk_bf16(acc[0] * ic - 32.f * x0[0], acc[1] * ic - 32.f * x0[1]); o.y = cvt_pk_bf16(acc[2] * ic - 32.f * x0[2], acc[3] * ic - 32.f * x0[3]);
            o.z = cvt_pk_bf16(acc[4] * ic - 32.f * x0[4], acc[5] * ic - 32.f * x0[5]); o.w = cvt_pk_bf16(acc[6] * ic - 32.f * x0[6], acc[7] * ic - 32.f * x0[7]);
            *(u32x4*)((unsigned char*)AM + (size_t)(t0 + i) * 2560 + 16 * lane) = o;
        }
        unsigned kw[8]; float cs[8], sn[8];
#pragma unroll
        for (int j = 0; j < 8; ++j) { const int ti = t0 + 2 * j + (lane >> 5), pr = lane & 31; kw[j] = *(const unsigned*)(Z + (size_t)ti * DINP + 1536 + 2 * pr); cs[j] = RP[(size_t)ti * 64 + pr]; sn[j] = RP[(size_t)ti * 64 + 32 + pr]; }
#pragma unroll
        for (int j = 0; j < 8; ++j) { const int ti = t0 + 2 * j + (lane >> 5), pr = lane & 31; const float x1 = bf_lo(kw[j]), x2 = bf_hi(kw[j]);
            *(unsigned short*)((unsigned char*)KR + (size_t)ti * 64 + 2 * pr) = (unsigned short)__builtin_amdgcn_cvt_pk_fp8_f32(32.f * (x1 * cs[j] - x2 * sn[j]), 32.f * (x2 * cs[j] + x1 * sn[j]), 0, false); }
    }
}

constexpr int N_PHASES = 12;
constexpr float C2 = 0.07216878364870322f * 1.4426950408889634f;
__global__ void __launch_bounds__(NTHR, 2) hymba_fwd(Args a) {
    __builtin_assume(__builtin_amdgcn_workitem_id_y() == 0); __builtin_assume(__builtin_amdgcn_workitem_id_z() == 0);
    extern __shared__ __attribute__((aligned(16))) unsigned char lds_raw[];
    LAS unsigned char* lds = (LAS unsigned char*)lds_raw;
    cg::grid_group grid = cg::this_grid();
    const int tid = threadIdx.x, lane = tid & 63, wave = __builtin_amdgcn_readfirstlane(tid >> 6);
    const int G = gridDim.x; const int bx = blockIdx.x; const int vcu = (G % 8 == 0) ? (bx % 8) * (G / 8) + bx / 8 : bx;
    unsigned char* ws = a.ws;
    u64* ctl = (u64*)(ws + WS_CTL);
    const int lo = a.ph_lo, hi = a.ph_hi;
#define IN(k) (lo <= (k) && (k) < hi)
#if PROBE_PHASE >= 0
    unsigned long long* tsb = (unsigned long long*)(ws + WS_CTL + 5 * (size_t)T * 8);
#define STAMP(k) do { if (bx == 0 && tid == 0) tsb[k] = __builtin_amdgcn_s_memrealtime(); } while (0)
#else
#define STAMP(k) do { } while (0)
#endif
    volatile LAS unsigned* xbst = (volatile LAS unsigned*)(lds + LDS_BYTES - 16);
    if (tid < 4) xbst[tid] = 0u;
    __syncthreads();
    const XcdBarrier xbar = xcd_barrier_post((unsigned*)(ws + WS_BAR), xbst);
#define SEAM(k) do { if (IN(k) && IN((k) + 1)) { if ((k) == 0) grid.sync(); else xcd_barrier(xbar); } STAMP((k) + 1); } while (0)
    STAMP(0);

#define FRESH_IDS() int tid_ = (int)threadIdx.x; asm volatile("" : "+v"(tid_)); const int lane_ = tid_ & 63, wave_ = __builtin_amdgcn_readfirstlane(tid_ >> 6)
    if (IN(0)) { p0_prologue(a, lds, vcu, G, tid, lane, wave); }
    SEAM(0);
    if (IN(1)) {
        pg8::Gemm g{(const bf16_t*)(ws + WS_AB), (const bf16_t*)(ws + WS_WIN), D, D, D, 0}; pg8::StaticOrder S; S.init(T / 256, DINP / 256, G, bx);
        pg8::EpiBf16<DINP, false, true, false, 1> E{(bf16_t*)(ws + WS_Z), nullptr, 0.f, 1.f, ctl, ctl + T, nullptr, lds, (unsigned char*)(ws + WS_EID)};
        pg8::gemm_phase<pg8::EpiBf16<DINP, false, true, false, 1>, pg8::StaticOrder, true, true>(lds, g, S, E);
        const int c0 = (T / 256) * (DINP / 256) - 3 * G;
        pg8::Gemm g2{(const bf16_t*)(ws + WS_PB), (const bf16_t*)(ws + WS_WP), DPLE, DPLE, DPLE, 0}; pg8::TailOrder S2; S2.init(T / 256, D / 256, G, bx, (c0 > 0 && c0 < G) ? c0 : 0);
        pg8::EpiBf16<D, false, false, false> E2{(bf16_t*)(ws + WS_PROJ), nullptr, 0.f, 1.f, nullptr, nullptr, nullptr, lds, nullptr};
        pg8::gemm_phase<pg8::EpiBf16<D, false, false, false>, pg8::TailOrder, true, true>(lds, g2, S2, E2);
    }
    SEAM(1);
    if (IN(2)) {
        { FRESH_IDS(); p2_pool_kr(a, vcu, G, lane_, wave_); }
        { pg8::Gemm g{(const bf16_t*)(ws + WS_EID), (const bf16_t*)(ws + WS_WUQ), 512, 256, 256, 0}; pg8::StaticOrder S; S.init(T / 256, NQ / 256, G, bx);
          pg8::EpiBf16<NQ, true, false, true, 2> E{nullptr, ctl, 1.f / 512.f, C2 * 256.f / (32.f * 1024.f), nullptr, nullptr, (const float*)(ws + WS_ROPE), lds, (unsigned char*)(ws + WS_Q)};
          pg8::gemm_phase<pg8::EpiBf16<NQ, true, false, true, 2>, pg8::StaticOrder, true, true, true>(lds, g, S, E); }
        { pg8::Gemm g{(const bf16_t*)(ws + WS_EID) + 256, (const bf16_t*)(ws + WS_WUKV), 512, 256, 256, 0}; pg8::StaticOrder S; S.init(T / 256, NKV / 256, G, bx);
          pg8::EpiBf16<1536, true, false, false, 3> E{(bf16_t*)(ws + WS_KV + 48 * MiB), ctl + T, 1.f / 512.f, 1.f / (32.f * 1024.f), nullptr, nullptr, nullptr, lds, (unsigned char*)(ws + WS_KV)};
          pg8::gemm_phase<pg8::EpiBf16<1536, true, false, false, 3>, pg8::StaticOrder, true, true, true>(lds, g, S, E); }
    }
    SEAM(2);
    if (IN(3)) {
        const bf16_t* Qm = (const bf16_t*)(ws + WS_Q); const bf16_t* KVm = (const bf16_t*)(ws + WS_KV); const bf16_t* KRm = (const bf16_t*)(ws + WS_KR); bf16_t* Om = (bf16_t*)(ws + WS_AMIX);
        for (int L = vcu; L < NB * NH * 16; L += G) { const int bh = L >> 4, x = L & 15, b = bh / NH, h = bh % NH;
            att::attn_unit(b, h, 31 - x, Qm, KVm, KRm, Om, (char*)lds_raw);
            att::attn_unit(b, h, x, Qm, KVm, KRm, Om, (char*)lds_raw); }
    }
    SEAM(3);
    if (IN(4)) {
        pg8::Gemm g{(const bf16_t*)(ws + WS_AMIX), (const bf16_t*)(ws + WS_WO), 1280, 1280, 1280, 0}; pg8::StaticOrder S; S.init(T / 256, D / 256, G, bx);
        pg8::EpiResF32 E{(bf16_t*)(ws + WS_AB), (const float*)(ws + WS_CTL + 5 * (size_t)T * 8 + 4096), ctl + 2 * T, lds, 1.f / (32.f * 1024.f)};
        pg8::gemm_phase<pg8::EpiResF32, pg8::StaticOrder, true, true, false, 8>(lds, g, S, E);
    }
    SEAM(4);
    if (IN(5)) {
        pg8::Gemm g{(const bf16_t*)(ws + WS_AB), (const bf16_t*)(ws + WS_WQ), D, D, D, 0}; pg8::StaticOrder S; S.init(T / 256, D / 256, G, bx);
        pg8::EpiBf16<D, true, false, false> E{(bf16_t*)(ws + WS_Q), ctl + 2 * T, 1.f / D, 1.f, nullptr, nullptr, nullptr, lds, nullptr};
        pg8::gemm_phase<pg8::EpiBf16<D, true, false, false>, pg8::StaticOrder, true, true>(lds, g, S, E);
    }
    if (IN(5) && IN(6)) { asm volatile("s_waitcnt vmcnt(0) lgkmcnt(0)" ::: "memory"); __builtin_amdgcn_fence(__ATOMIC_ACQ_REL, "workgroup"); __syncthreads(); }
    STAMP(6);
    if (IN(6)) {
        pg8::Gemm g{(const bf16_t*)(ws + WS_Q), (const bf16_t*)(ws + WS_SK), D, 256, 256, 256};
        pg8::EpiTopK E{(unsigned short*)(ws + WS_EID), (float*)(ws + WS_GATE)};
        pg8::StaticOrder So; So.init(T / 256, PH, G, bx);
        for (int i = 0;; ++i) { int upm, upn; { pg8::Unit uu; if (!So.next(i, uu)) break; upm = uu.pm; upn = uu.pn; } pg8::SingleUnit S; S.u0.pm = upm; S.u0.pn = upn;
            pg8::gemm_phase<pg8::EpiTopK, pg8::SingleUnit, false, true>(lds, g, S, E); }
    }
    SEAM(6);
    if (IN(7)) { FRESH_IDS(); p7a_upass(a, bx, G, lane_, wave_, lds); }
    SEAM(7);
    if (IN(8)) { FRESH_IDS(); p7b_apass(a, vcu, G, tid_); }
    SEAM(8);
    if (IN(9)) { FRESH_IDS(); p7c_vpass(a, bx, G, lane_, wave_, lds); }
    SEAM(9);
    if (IN(10)) {
        pg8::Gemm g{(const bf16_t*)(ws + WS_KV), (const bf16_t*)(ws + WS_WG), D / 2, D / 2, D / 2, 0}; pg8::StaticOrder S; S.init(T / 256, D / 256, G, bx);
        pg8::EpiPle E{(const bf16_t*)(ws + WS_AB), (bf16_t*)(ws + WS_AMIX), (const bf16_t*)(ws + WS_PROJ), (const float*)(ws + WS_GATE), ctl + 3 * T, lds, 1.f / (32.f * 1024.f)};
        pg8::gemm_phase<pg8::EpiPle, pg8::StaticOrder, true, true, true>(lds, g, S, E);
    }
    SEAM(10);
    float oscale = 1.f;
#if PROBE_PHASE >= 0
    { const float frac = (float)(tsb[PROBE_PHASE + 1] - tsb[PROBE_PHASE]) / (float)(tsb[11] - tsb[0]); oscale = 1.f + sqrtf(0.01f + frac); }
#endif
    if (IN(11)) { FRESH_IDS(); p8_final(a, vcu, G, lane_, wave_, oscale); }
#undef FRESH_IDS
#undef IN
#undef SEAM
}

extern "C" void kernel_launch(void* const* d_in, const int* in_sizes, int n_in, void* d_out, int out_size, void* d_ws, size_t ws_size, hipStream_t stream) {
    static int grid = 0;
    if (grid == 0) {
        if (n_in != 21 || out_size != T * D || ws_size < WS_END) { fprintf(stderr, "kernel_launch: unexpected shapes (n_in %d, out %d, ws %zu)\n", n_in, out_size, ws_size); grid = -1; return; }
        int dev = 0, cus = 0, per_cu = 0;
        hipGetDevice(&dev); hipDeviceGetAttribute(&cus, hipDeviceAttributeMultiprocessorCount, dev);
        if (hipFuncSetAttribute((const void*)hymba_fwd, hipFuncAttributeMaxDynamicSharedMemorySize, LDS_BYTES) != hipSuccess) { fprintf(stderr, "kernel_launch: hipFuncSetAttribute failed\n"); grid = -1; return; }
        if (hipOccupancyMaxActiveBlocksPerMultiprocessor(&per_cu, (const void*)hymba_fwd, NTHR, LDS_BYTES) != hipSuccess || per_cu < 1) { fprintf(stderr, "kernel_launch: occupancy query says %d\n", per_cu); grid = -1; (void)hipGetLastError(); return; }
        grid = cus;
    }
    if (grid < 0) return;
    Args a{};
    a.x = (const float*)d_in[0]; a.p = (const float*)d_in[1]; a.positions = (const int*)d_in[2]; a.mix_g = (const float*)d_in[3]; a.w_in = (const float*)d_in[4];
    a.pool_w = (const float*)d_in[5]; a.pool_scale = (const float*)d_in[6]; a.q_g = (const float*)d_in[7]; a.w_uq = (const float*)d_in[8]; a.kv_g = (const float*)d_in[9];
    a.w_ukv = (const float*)d_in[10]; a.w_o = (const float*)d_in[11]; a.ffn_g = (const float*)d_in[12]; a.peer_wq = (const float*)d_in[13]; a.sub_keys = (const float*)d_in[14];
    a.peer_u = (const float*)d_in[15]; a.peer_v = (const float*)d_in[16]; a.ple_g = (const float*)d_in[17]; a.ple_wg = (const float*)d_in[18]; a.ple_wp = (const float*)d_in[19];
    a.final_g = (const float*)d_in[20];
    a.out = (float*)d_out; a.ws = (unsigned char*)d_ws; a.ph_lo = 0; a.ph_hi = N_PHASES;
    if (hipMemsetAsync((char*)d_ws + WS_BAR, 0, XCD_BAR_WORDS * 4, stream) != hipSuccess) { fprintf(stderr, "kernel_launch: memset of the barrier words failed\n"); return; }
    void* args[] = {&a};
    hipError_t e = hipLaunchCooperativeKernel((const void*)hymba_fwd, dim3(grid), dim3(NTHR), args, LDS_BYTES, stream);
    if (e != hipSuccess) fprintf(stderr, "kernel_launch: cooperative launch failed: %s (grid %d)\n", hipGetErrorString(e), grid);
}
```

```cpp
#include <hip/hip_runtime.h>
#include <hip/hip_cooperative_groups.h>
#include <cstdio>
#include <cstdint>
namespace cg = cooperative_groups;

#define LAS __attribute__((address_space(3)))
typedef unsigned short bf16_t;
typedef short bf16x8 __attribute__((ext_vector_type(8)));
typedef float f32x4 __attribute__((ext_vector_type(4)));
typedef float f32x2 __attribute__((ext_vector_type(2)));
typedef unsigned u32x4 __attribute__((ext_vector_type(4)));
typedef unsigned u32x2 __attribute__((ext_vector_type(2)));
typedef int v4i32 __attribute__((ext_vector_type(4)));
typedef int v2i32 __attribute__((ext_vector_type(2)));
typedef int v8i32 __attribute__((ext_vector_type(8)));

constexpr int T = 32768, SEQ = 8192, NB = 4, D = 2048, DIN = 1600, DINP = 1792, DPOOL = 512, DPLE = 256;
constexpr int NH = 12, QKD = 192, NQ = NH * QKD  , NKV = NH * 256  , DATT = 1536;
constexpr int PH = 8, PK = 128, PTOP = 16, NEXP = 16384;
constexpr float EPS = 1e-6f;
constexpr int NWAVES = 8, NTHR = 512;

constexpr size_t MiB = 1u << 20;
constexpr size_t WS_CTL = 868 * MiB;
constexpr size_t WS_WIN = 1 * MiB;
constexpr size_t WS_WUQ = 8 * MiB;
constexpr size_t WS_WUKV = 11 * MiB;
constexpr size_t WS_WO = 14 * MiB;
constexpr size_t WS_WQ = 22 * MiB;
constexpr size_t WS_SK = 30 * MiB;
constexpr size_t WS_WG = 31 * MiB;
constexpr size_t WS_WP = 39 * MiB;
constexpr size_t WS_ROPE = 40 * MiB;
constexpr size_t WS_KR = 48 * MiB;
constexpr size_t WS_PB = 52 * MiB;
constexpr size_t WS_EID = 68 * MiB;
constexpr size_t WS_GATE = 84 * MiB;
constexpr size_t WS_UT = 100 * MiB;
constexpr size_t WS_VT = 132 * MiB;
constexpr size_t WS_AB = 164 * MiB;
constexpr size_t WS_Z = 292 * MiB;
constexpr size_t WS_Q = 404 * MiB;
constexpr size_t WS_KV = 548 * MiB;
constexpr size_t WS_AMIX = 740 * MiB;
constexpr size_t WS_BAR = WS_CTL + 3 * MiB / 2;
constexpr size_t WS_PROJ = 870 * MiB;
constexpr size_t WS_SU = WS_CTL + 13 * MiB / 8;
constexpr size_t WS_SV = WS_CTL + 14 * MiB / 8;
constexpr size_t WS_END = 998 * MiB;

#define ATTN_ZERO 0
#ifndef PROBE_PHASE
#define PROBE_PHASE -1
#endif
constexpr int LDS_BYTES = 148480;

typedef __bf16 bf16x2_t __attribute__((ext_vector_type(2)));
__device__ __forceinline__ unsigned cvt_pk_bf16(float lo, float hi) { f32x2 v = {lo, hi}; bf16x2_t b = __builtin_convertvector(v, bf16x2_t); return __builtin_bit_cast(unsigned, b); }
__device__ __forceinline__ float bf_lo(unsigned w) { return __uint_as_float(w << 16); }
__device__ __forceinline__ float bf_hi(unsigned w) { return __uint_as_float(w & 0xffff0000u); }
__device__ __forceinline__ float wave_sum(float v) {
#pragma unroll
    for (int o = 1; o < 64; o <<= 1) v += __shfl_xor(v, o);
    return v;
}
#define DPPF(v, ctrl) __builtin_bit_cast(float, __builtin_amdgcn_update_dpp(0, __builtin_bit_cast(int, (v)), (ctrl), 0xF, 0xF, true))
__device__ __forceinline__ float wave_sum_dpp(float v) {
    v += DPPF(v, 0xB1); v += DPPF(v, 0x4E); v += DPPF(v, 0x141); v += DPPF(v, 0x140);
    const int b = __builtin_bit_cast(int, v);
    return (__builtin_bit_cast(float, __builtin_amdgcn_readlane(b, 0)) + __builtin_bit_cast(float, __builtin_amdgcn_readlane(b, 16))) + (__builtin_bit_cast(float, __builtin_amdgcn_readlane(b, 32)) + __builtin_bit_cast(float, __builtin_amdgcn_readlane(b, 48)));
}
#define LDS_WAIT() asm volatile("s_waitcnt lgkmcnt(0)" ::: "memory")
typedef unsigned long long u64;
__device__ __forceinline__ void ssq_add(u64* p, float ss) { atomicAdd(p, (u64)(ss * 1048576.f + 0.5f)); }
__device__ __forceinline__ float ssq_get(const u64* p) { return (float)(*p) * (1.f / 1048576.f); }

namespace pg8 {
constexpr int BM = 256, BK = 64, HALF = 128, HTB = HALF * BK * 2, STAGE_BYTES = 8 * HTB, NXCD = 8, WGM = 8;
__host__ __device__ __forceinline__ int lds_byte(int r, int c) { const int st = (r >> 4) * 2 + (c >> 5), rr = r & 15, cc = c & 31, ob = rr * 64 + cc * 2; return st * 1024 + (ob ^ (((ob >> 9) & 1) << 5)); }
__host__ __device__ __forceinline__ void stage_rc(int b, int& R, int& C) { const int st = b / 1024, sb = b % 1024, swz = sb ^ (((sb >> 9) & 1) << 5); R = (st >> 1) * 16 + swz / 64; C = (st & 1) * 32 + (swz % 64) / 2; }
__host__ __device__ __forceinline__ int perm32(int rho) { const int n = rho >> 4, i = rho & 15; return 8 * (i >> 2) + 4 * n + (i & 3); }

struct Unit { int pm, pn; };
struct Gemm { const bf16_t* A; const bf16_t* Bt; int lda, ldb, K, acol_pn; };

struct StaticOrder {
    int nM, nN, nwg, G, c;
    __device__ void init(int nM_, int nN_, int G_, int c_) { nM = nM_; nN = nN_; nwg = nM * nN; G = G_; c = c_; }
    __device__ __forceinline__ bool next(int i, Unit& u) const {
        const long L = (long)i * G + c; if (L >= nwg) return false;
        int wgid = (int)L; { const int q = nwg / NXCD, r = nwg % NXCD, xcd = wgid % NXCD, off = wgid / NXCD; wgid = (xcd < r ? xcd * (q + 1) : r * (q + 1) + (xcd - r) * q) + off; }
        const int nig = WGM * nN, gid = wgid / nig, fm = gid * WGM, gsz = (nM - fm) < WGM ? (nM - fm) : WGM;
        u.pm = fm + ((wgid % nig) % gsz); u.pn = (wgid % nig) / gsz; return true;
    }
};
struct TailOrder {
    int nN, nwg, Gt, ct;
    __device__ void init(int nM_, int nN_, int G_, int c_, int c0) { nN = nN_; nwg = nM_ * nN_; Gt = G_ - c0; ct = c_ - c0; }
    __device__ bool next(int i, Unit& u) const { if (ct < 0) return false; const long L = (long)i * Gt + ct; if (L >= nwg) return false; u.pm = (int)L / nN; u.pn = (int)L % nN; return true; }
};
struct SingleUnit {
    Unit u0;
    __device__ bool next(int i, Unit& u) const { if (i > 0) return false; u = u0; return true; }
};

template <class Epi, class Sched, bool ALIGN_EPI, bool SP2, bool FP8 = false, int MIXK = 0, bool BDIAG = false>
__device__ __forceinline__ void gemm_phase(LAS unsigned char* lds, const Gemm g, const Sched& S, const Epi& E) {
    const int tid = threadIdx.x, wid = __builtin_amdgcn_readfirstlane(tid >> 6), lane = tid & 63, wr = wid >> 2, wc = wid & 3, fr = lane & 15, fq = lane >> 4;
    int K_ = g.K; asm volatile("" : "+s"(K_));
    const int K = K_, nt = K / BK;
    unsigned voffA[2], voffB[2];
#pragma unroll
    for (int i = 0; i < 2; ++i) { int R, C; stage_rc(tid * 16 + i * 8192, R, C); const int Rb = Epi::PERM ? ((R & ~31) + perm32(R & 31)) : R;
        voffA[i] = (unsigned)(R * g.lda + C) * 2u; voffB[i] = (unsigned)(Rb * g.ldb + C) * 2u; }
    const size_t kstep = (size_t)(BK * 2);
    const size_t hstepA = (size_t)HALF * g.lda * 2, hstepB = (size_t)HALF * g.ldb * 2;
    const size_t tstepA = 2 * hstepA, tstepB = 2 * hstepB;
    const unsigned ldsw = (unsigned)wid * 1024u;
    const int aoff = lds_byte(wr * 64 + fr, fq * 8), boff = lds_byte(wc * 32 + fr, fq * 8);
#define PG8_SA(b, h) (((b) * 2 + (h)) * HTB)
#define PG8_SB(b, h) ((4 + (b) * 2 + (h)) * HTB)
#define PG8_STAGE(bufoff, gbase, voff) do { _Pragma("unroll") for (int _i = 0; _i < 2; ++_i) \
        __builtin_amdgcn_global_load_lds((const unsigned*)((const char*)(gbase) + (voff)[_i]), (LAS unsigned*)(lds + (bufoff) + ldsw + _i * 8192), 16, 0, 0); } while (0)
#define PG8_LDA_(dst, b, h, F8) do { _Pragma("unroll") for (int m = 0; m < 4; ++m) { if constexpr (F8) { const v4i32 lo_ = *(const LAS v4i32*)(lds + PG8_SA(b, h) + aoff + m * 2048), hi_ = *(const LAS v4i32*)(lds + PG8_SA(b, h) + aoff + m * 2048 + 1024); \
            dst##8[m] = __builtin_shufflevector(lo_, hi_, 0, 1, 2, 3, 4, 5, 6, 7); } \
        else { _Pragma("unroll") for (int k = 0; k < 2; ++k) dst[m][k] = *(const LAS bf16x8*)(lds + PG8_SA(b, h) + aoff + m * 2048 + k * 1024); } } } while (0)
#define PG8_LDB_(dst, b, h, F8) do { _Pragma("unroll") for (int n = 0; n < 2; ++n) { if constexpr (F8) { const v4i32 lo_ = *(const LAS v4i32*)(lds + PG8_SB(b, h) + boff + n * 2048), hi_ = *(const LAS v4i32*)(lds + PG8_SB(b, h) + boff + n * 2048 + 1024); \
            dst##8[n] = __builtin_shufflevector(lo_, hi_, 0, 1, 2, 3, 4, 5, 6, 7); } \
        else { _Pragma("unroll") for (int k = 0; k < 2; ++k) dst[n][k] = *(const LAS bf16x8*)(lds + PG8_SB(b, h) + boff + n * 2048 + k * 1024); } } } while (0)
#define PG8_MMA_(ai, bj, At, Bt, F8) do { if (BDIAG && (bj) != (t >> 1)) break; __builtin_amdgcn_s_setprio(1); _Pragma("unroll") for (int m = 0; m < 4; ++m) _Pragma("unroll") for (int n = 0; n < 2; ++n) { \
        if constexpr (F8) asm volatile("v_mfma_f32_16x16x128_f8f6f4 %0, %1, %2, %0" : "+v"(acc[ai][bj][m][n]) : "v"(Bt##8[n]), "v"(At##8[m]));     \
          \
          \
        else { _Pragma("unroll") for (int k = 0; k < 2; ++k) acc[ai][bj][m][n] = __builtin_amdgcn_mfma_f32_16x16x32_bf16(Bt[n][k], At[m][k], acc[ai][bj][m][n], 0, 0, 0); } } \
        __builtin_amdgcn_s_setprio(0); } while (0)
#define PG8_LDA(dst, b, h) PG8_LDA_(dst, b, h, FP8)
#define PG8_LDB(dst, b, h) PG8_LDB_(dst, b, h, FP8)
#define PG8_MMA(ai, bj, At, Bt) PG8_MMA_(ai, bj, At, Bt, FP8)
#define PG8_WAIT_V(n) asm volatile("s_waitcnt vmcnt(" #n ")" ::: "memory")
#define PG8_WAIT_L(n) asm volatile("s_waitcnt lgkmcnt(" #n ")" ::: "memory")
#define PG8_BAR __builtin_amdgcn_s_barrier()
#define PG8_SCHED __builtin_amdgcn_sched_barrier(0)
    Unit cur, nxt; int ui = 0;
    if (!S.next(0, cur)) return;
    f32x4 acc[2][2][4][2];
#pragma unroll
    for (int a = 0; a < 2; ++a)
#pragma unroll
        for (int b = 0; b < 2; ++b)
#pragma unroll
            for (int m = 0; m < 4; ++m)
#pragma unroll
                for (int n = 0; n < 2; ++n) acc[a][b][m][n] = (f32x4){0.f, 0.f, 0.f, 0.f};
    int one_e8m0 = 0x7f7f7f7f; asm volatile("" : "+v"(one_e8m0));
    bf16x8 At[4][2], B0[2][2], B1[2][2]; v8i32 At8[4], B08[2], B18[2];
    const char* cA = (const char*)g.A + (size_t)cur.pm * tstepA + (size_t)cur.pn * g.acol_pn * 2; const char* cB = (const char*)g.Bt + (size_t)cur.pn * tstepB;
    if constexpr (SP2) {
        PG8_STAGE(PG8_SB(0, 0), cB, voffB); PG8_STAGE(PG8_SB(0, 1), cB + hstepB, voffB); PG8_STAGE(PG8_SA(0, 0), cA, voffA); PG8_STAGE(PG8_SA(0, 1), cA + hstepA, voffA);
        if (wr == 1) PG8_BAR;
        PG8_WAIT_V(2); PG8_BAR;
        PG8_STAGE(PG8_SB(1, 0), cB + kstep, voffB); PG8_STAGE(PG8_SA(1, 0), cA + kstep, voffA); PG8_STAGE(PG8_SB(1, 1), cB + hstepB + kstep, voffB);
        PG8_WAIT_V(6); PG8_BAR;
    } else {
        PG8_STAGE(PG8_SB(0, 0), cB, voffB); PG8_STAGE(PG8_SA(0, 0), cA, voffA); PG8_STAGE(PG8_SB(0, 1), cB + hstepB, voffB); PG8_STAGE(PG8_SA(0, 1), cA + hstepA, voffA);
        if (wr == 1) PG8_BAR;
        PG8_WAIT_V(4); PG8_BAR;
        PG8_STAGE(PG8_SB(1, 0), cB + kstep, voffB); PG8_STAGE(PG8_SA(1, 0), cA + kstep, voffA); PG8_STAGE(PG8_SB(1, 1), cB + hstepB + kstep, voffB);
        PG8_WAIT_V(6); PG8_BAR;
    }
    for (;;) {
        const bool has_next = S.next(ui + 1, nxt);
        const char* nA = has_next ? (const char*)g.A + (size_t)nxt.pm * tstepA + (size_t)nxt.pn * g.acol_pn * 2 : cA; const char* nB = has_next ? (const char*)g.Bt + (size_t)nxt.pn * tstepB : cB;
#define PG8_SP2_TRIP(F8) do { \
            PG8_LDB_(B0, 0, 0, F8); PG8_LDB_(B1, 0, 1, F8); PG8_SCHED; PG8_LDA_(At, 0, 0, F8); PG8_STAGE(PG8_SA(1, 1), a1 + hstepA, voffA); \
            PG8_WAIT_V(8); PG8_WAIT_L(0); PG8_BAR; PG8_MMA_(0, 0, At, B0, F8); PG8_MMA_(0, 1, At, B1, F8); PG8_BAR; PG8_SCHED; \
            PG8_LDA_(At, 0, 1, F8); PG8_STAGE(PG8_SB(0, 0), b2, voffB); PG8_STAGE(PG8_SB(0, 1), b2 + hstepB, voffB); PG8_STAGE(PG8_SA(0, 0), a2, voffA); \
            PG8_WAIT_V(8); PG8_WAIT_L(0); PG8_BAR; PG8_MMA_(1, 0, At, B0, F8); PG8_MMA_(1, 1, At, B1, F8); PG8_BAR; PG8_SCHED; \
            PG8_LDB_(B0, 1, 0, F8); PG8_LDB_(B1, 1, 1, F8); PG8_SCHED; PG8_LDA_(At, 1, 0, F8); PG8_STAGE(PG8_SA(0, 1), a2 + hstepA, voffA); \
            PG8_WAIT_V(8); PG8_WAIT_L(0); PG8_BAR; PG8_MMA_(0, 0, At, B0, F8); PG8_MMA_(0, 1, At, B1, F8); PG8_BAR; PG8_SCHED; \
            PG8_LDA_(At, 1, 1, F8); PG8_STAGE(PG8_SB(1, 0), b3, voffB); PG8_STAGE(PG8_SB(1, 1), b3 + hstepB, voffB); PG8_STAGE(PG8_SA(1, 0), a3, voffA); \
            PG8_WAIT_V(8); PG8_WAIT_L(0); PG8_BAR; PG8_MMA_(1, 0, At, B0, F8); PG8_MMA_(1, 1, At, B1, F8); PG8_BAR; PG8_SCHED; } while (0)
#define PG8_ADDR const bool last = (t == nt - 2); const char* a1 = cA + (size_t)(t + 1) * kstep; \
            const char* a2 = last ? nA : cA + (size_t)(t + 2) * kstep; const char* b2 = last ? nB : cB + (size_t)(t + 2) * kstep; \
            const char* a3 = a2 + kstep; const char* b3 = b2 + kstep;
        int tmix = MIXK; asm volatile("" : "+s"(tmix));
        if constexpr (SP2 && MIXK > 0) { for (int t = 0; t < tmix; t += 2) { PG8_ADDR PG8_SP2_TRIP(false); } }
        for (int t = (SP2 && MIXK > 0) ? tmix : 0; t < nt; t += 2) {
            PG8_ADDR
            if constexpr (SP2) {
            if constexpr (MIXK > 0) PG8_SP2_TRIP(true); else PG8_SP2_TRIP(FP8);
            } else {
            PG8_LDB(B0, 0, 0); PG8_SCHED; PG8_LDA(At, 0, 0); PG8_STAGE(PG8_SA(1, 1), a1 + hstepA, voffA);
            PG8_WAIT_L(8); PG8_BAR; PG8_WAIT_L(0); PG8_MMA(0, 0, At, B0); PG8_BAR; PG8_SCHED;
            PG8_LDB(B1, 0, 1); PG8_STAGE(PG8_SB(0, 0), b2, voffB);
            PG8_BAR; PG8_WAIT_L(0); PG8_MMA(0, 1, At, B1); PG8_BAR;
            PG8_LDA(At, 0, 1); PG8_STAGE(PG8_SA(0, 0), a2, voffA);
            PG8_BAR; PG8_WAIT_L(0); PG8_MMA(1, 0, At, B0); PG8_BAR; PG8_SCHED;
            PG8_STAGE(PG8_SB(0, 1), b2 + hstepB, voffB);
            PG8_WAIT_V(6); PG8_BAR; PG8_MMA(1, 1, At, B1); PG8_BAR;
            PG8_LDB(B0, 1, 0); PG8_SCHED; PG8_LDA(At, 1, 0); PG8_STAGE(PG8_SA(0, 1), a2 + hstepA, voffA);
            PG8_WAIT_L(8); PG8_BAR; PG8_WAIT_L(0); PG8_MMA(0, 0, At, B0); PG8_BAR; PG8_SCHED;
            PG8_LDB(B1, 1, 1); PG8_STAGE(PG8_SB(1, 0), b3, voffB);
            PG8_BAR; PG8_WAIT_L(0); PG8_MMA(0, 1, At, B1); PG8_BAR;
            PG8_LDA(At, 1, 1); PG8_STAGE(PG8_SA(1, 0), a3, voffA);
            PG8_BAR; PG8_WAIT_L(0); PG8_MMA(1, 0, At, B0); PG8_BAR; PG8_SCHED;
            PG8_STAGE(PG8_SB(1, 1), b3 + hstepB, voffB);
            PG8_WAIT_V(6); PG8_BAR; PG8_MMA(1, 1, At, B1); PG8_BAR;
            }
        }
        if constexpr (ALIGN_EPI) { if (wr == 0) PG8_BAR; }
        if constexpr (FP8 || MIXK > 0) asm volatile("s_nop 15\n\ts_nop 7" ::: "memory");
        if constexpr (!Epi::AFTER_DRAIN) { E(acc, cur, wr, wc, fr, fq); }
        if (!has_next) break;
#pragma unroll
        for (int a = 0; a < 2; ++a)
#pragma unroll
            for (int b = 0; b < 2; ++b)
#pragma unroll
                for (int m = 0; m < 4; ++m)
#pragma unroll
                    for (int n = 0; n < 2; ++n) acc[a][b][m][n] = (f32x4){0.f, 0.f, 0.f, 0.f};
        cur = nxt; cA = nA; cB = nB; ++ui;
        if constexpr (ALIGN_EPI) { if (wr == 1) PG8_BAR; }
    }
    PG8_WAIT_V(0);
    if constexpr (!ALIGN_EPI) { if (wr == 0) PG8_BAR; }
    PG8_BAR;
    if constexpr (Epi::AFTER_DRAIN) { E.fused(acc, cur, wr, wc, fr, fq, lds, wid, lane); }
#undef PG8_SA
#undef PG8_SB
#undef PG8_STAGE
#undef PG8_LDA
#undef PG8_LDB
#undef PG8_MMA
#undef PG8_LDA_
#undef PG8_LDB_
#undef PG8_MMA_
#undef PG8_SP2_TRIP
#undef PG8_ADDR
#undef PG8_WAIT_V
#undef PG8_WAIT_L
#undef PG8_BAR
#undef PG8_SCHED
}


__device__ __forceinline__ void row_ssq_flush(LAS unsigned char* lds, const float (&ss)[2][4], int pm, int wr, int wc, int fr, int fq, u64* dst) {
    LAS float* P = (LAS float*)(lds + STAGE_BYTES);
    if (fq == 0) {
#pragma unroll
        for (int ai = 0; ai < 2; ++ai)
#pragma unroll
            for (int m = 0; m < 4; ++m) P[(ai * HALF + wr * 64 + m * 16 + fr) * 4 + wc] = ss[ai][m]; }
    asm volatile("s_waitcnt lgkmcnt(0)" ::: "memory"); __builtin_amdgcn_s_barrier(); asm volatile("" ::: "memory");
    const int tid = (wr * 4 + wc) * 64 + fq * 16 + fr;
    if (tid < 256) { const f32x4 p = *(const LAS f32x4*)(P + tid * 4); ssq_add(dst + pm * BM + tid, (p[0] + p[1]) + (p[2] + p[3])); }
}


template <int LDC, bool RS, bool SSQ, bool ROPE, int F8MODE = 0> struct EpiBf16 {
    static constexpr bool PERM = true, AFTER_DRAIN = false;
    bf16_t* O; const u64* ssq_in; float inv_n, mul; u64* ssq_a; u64* ssq_b; const float* rope; LAS unsigned char* lds; unsigned char* O8;
    __device__ __forceinline__ void store_vt(const f32x4 (&acc)[2][2][4][2], const Unit& u, int wr, int wc, int fr, int fq, const float (&scl)[2][4]) const {
        LAS unsigned char* VL = lds + STAGE_BYTES; const int tid = (wr * 4 + wc) * 64 + fq * 16 + fr;
#pragma unroll
        for (int cs = 0; cs < 4; ++cs) { const int ai = cs >> 1, wrs = cs & 1;
            if (wr == wrs) {
#pragma unroll
                for (int m = 0; m < 4; ++m) { const int key = 16 * m + fr, k32 = key & 31, pos = 32 * ((k32 >> 2) & 1) + 16 * (key >> 5) + 4 * (k32 >> 3) + (k32 & 3); const float sc = scl[ai][m] * 32.f;
#pragma unroll
                    for (int bj = 0; bj < 2; ++bj)
#pragma unroll
                        for (int n = 0; n < 2; ++n) { const f32x4 v = acc[ai][bj][m][n] * sc; const int d = 32 * wc + 8 * fq + 4 * n;
                            const unsigned w01 = (unsigned)__builtin_amdgcn_cvt_pk_fp8_f32(v[0], v[1], 0, false), w23 = (unsigned)__builtin_amdgcn_cvt_pk_fp8_f32(v[2], v[3], 0, false);
                            LAS unsigned char* q = VL + (bj * 128 + d) * 64 + pos;
                            q[0] = (unsigned char)(w01 & 0xffu); q[64] = (unsigned char)((w01 >> 8) & 0xffu); q[128] = (unsigned char)(w23 & 0xffu); q[192] = (unsigned char)((w23 >> 8) & 0xffu); } } }
            asm volatile("s_waitcnt lgkmcnt(0)" ::: "memory"); __builtin_amdgcn_s_barrier(); asm volatile("" ::: "memory");
            { const int token0 = u.pm * BM + 64 * cs, bb = token0 / SEQ, tile = (token0 % SEQ) / 64, bjc = tid >> 8, off = (tid & 255) * 32, hd = 2 * (u.pn - 6) + bjc;
              unsigned char* dst = (unsigned char*)O + ((size_t)(bb * NH + hd) * (SEQ / 64) + tile) * 8192 + off;
              const u32x4 x0 = *(const LAS u32x4*)(VL + bjc * 8192 + off), x1 = *(const LAS u32x4*)(VL + bjc * 8192 + off + 16);
              *(u32x4*)dst = x0; *(u32x4*)(dst + 16) = x1; }
            asm volatile("s_waitcnt lgkmcnt(0)" ::: "memory"); __builtin_amdgcn_s_barrier(); asm volatile("" ::: "memory");
        }
    }
    __device__ __forceinline__ void operator()(const f32x4 (&acc)[2][2][4][2], const Unit& u, int wr, int wc, int fr, int fq) const {
        const int row0 = u.pm * BM + wr * 64 + fr, col0 = u.pn * BM + wc * 32 + 8 * fq;
        const bool do_ssq = SSQ && u.pn >= 2 && u.pn < 6; float ssr[2][4];
        float scl[2][4];
        if constexpr (RS) { u64 q8[2][4];
#pragma unroll
            for (int ai = 0; ai < 2; ++ai)
#pragma unroll
                for (int m = 0; m < 4; ++m) q8[ai][m] = ssq_in[row0 + ai * HALF + m * 16];
#pragma unroll
            for (int ai = 0; ai < 2; ++ai)
#pragma unroll
                for (int m = 0; m < 4; ++m) scl[ai][m] = mul * rsqrtf((float)q8[ai][m] * (1.f / 1048576.f) * inv_n + EPS); }
        if constexpr (F8MODE == 3) { if (u.pn >= 6) { store_vt(acc, u, wr, wc, fr, fq, scl); return; } }
#pragma unroll
        for (int ai = 0; ai < 2; ++ai) {
#pragma unroll
            for (int m = 0; m < 4; ++m) {
                const int row = row0 + ai * HALF + m * 16;
                float sc = mul; if constexpr (RS) sc = scl[ai][m];
                float ss = 0.f;
#pragma unroll
                for (int bj = 0; bj < 2; ++bj) {
                    f32x4 v0 = acc[ai][bj][m][0] * sc, v1 = acc[ai][bj][m][1] * sc; const int col = col0 + bj * HALF;
                    if constexpr (ROPE) { const int cw = col % QKD;
                        if (cw >= 128) { const int i0 = (cw - 128) >> 1; const f32x4 cs = *(const f32x4*)(rope + (size_t)row * 64 + i0), sn = *(const f32x4*)(rope + (size_t)row * 64 + 32 + i0);
                            f32x4 a, b;
                            a[0] = v0[0] * cs[0] - v0[1] * sn[0]; a[1] = v0[1] * cs[0] + v0[0] * sn[0]; a[2] = v0[2] * cs[1] - v0[3] * sn[1]; a[3] = v0[3] * cs[1] + v0[2] * sn[1];
                            b[0] = v1[0] * cs[2] - v1[1] * sn[2]; b[1] = v1[1] * cs[2] + v1[0] * sn[2]; b[2] = v1[2] * cs[3] - v1[3] * sn[3]; b[3] = v1[3] * cs[3] + v1[2] * sn[3];
                            v0 = a; v1 = b; } }
                    if constexpr (SSQ) ss += (v0[0] * v0[0] + v0[1] * v0[1]) + (v0[2] * v0[2] + v0[3] * v0[3]) + (v1[0] * v1[0] + v1[1] * v1[1]) + (v1[2] * v1[2] + v1[3] * v1[3]);
                    const bool f8t = (F8MODE == 1 && do_ssq) || F8MODE == 2 || (F8MODE == 3 && u.pn < 6);
                    if (f8t) { const float fs = (F8MODE == 2) ? 1.f : 32.f;
                        int w0 = __builtin_amdgcn_cvt_pk_fp8_f32(v0[0] * fs, v0[1] * fs, 0, false); w0 = __builtin_amdgcn_cvt_pk_fp8_f32(v0[2] * fs, v0[3] * fs, w0, true);
                        int w1 = __builtin_amdgcn_cvt_pk_fp8_f32(v1[0] * fs, v1[1] * fs, 0, false); w1 = __builtin_amdgcn_cvt_pk_fp8_f32(v1[2] * fs, v1[3] * fs, w1, true);
                        unsigned char* dst = (F8MODE == 1) ? O8 + (size_t)row * 1024 + (col - 512) : O8 + (size_t)row * LDC + col;
                        *(u32x2*)dst = (u32x2){(unsigned)w0, (unsigned)w1}; }
                    else { u32x4 w; w.x = cvt_pk_bf16(v0[0], v0[1]); w.y = cvt_pk_bf16(v0[2], v0[3]); w.z = cvt_pk_bf16(v1[0], v1[1]); w.w = cvt_pk_bf16(v1[2], v1[3]);
                        *(u32x4*)(O + (size_t)row * LDC + (F8MODE == 3 ? col - 1536 : col)) = w; }
                }
                if constexpr (SSQ) { ss += __shfl_xor(ss, 16); ss += __shfl_xor(ss, 32); ssr[ai][m] = ss; }
                if constexpr (ROPE) asm volatile("" ::: "memory");
            }
            asm volatile("" ::: "memory");
        }
        if constexpr (SSQ) { if (do_ssq) row_ssq_flush(lds, ssr, u.pm, wr, wc, fr, fq, u.pn < 4 ? ssq_a : ssq_b); }
    }
};

struct EpiResF32 {
    static constexpr bool PERM = false, AFTER_DRAIN = false;
    bf16_t* io; const float* rms; u64* ssq; LAS unsigned char* lds; float ascale;
    __device__ __forceinline__ void operator()(const f32x4 (&acc)[2][2][4][2], const Unit& u, int wr, int wc, int fr, int fq) const {
        const int row0 = u.pm * BM + wr * 64 + fr, col0 = u.pn * BM + wc * 32 + 4 * fq; float ssr[2][4];
#pragma unroll
        for (int ai = 0; ai < 2; ++ai)
#pragma unroll
            for (int mp = 0; mp < 2; ++mp) { u32x2 xin[2][2][2]; float rm[2];
#pragma unroll
                for (int mm = 0; mm < 2; ++mm) { const int row = row0 + ai * HALF + (2 * mp + mm) * 16; rm[mm] = rms[row];
#pragma unroll
                    for (int bj = 0; bj < 2; ++bj)
#pragma unroll
                        for (int n = 0; n < 2; ++n) xin[mm][bj][n] = *(const u32x2*)(io + (size_t)row * D + col0 + bj * HALF + n * 16); }
#pragma unroll
                for (int mm = 0; mm < 2; ++mm) { const int m = 2 * mp + mm, row = row0 + ai * HALF + m * 16; float ss = 0.f;
#pragma unroll
                    for (int bj = 0; bj < 2; ++bj)
#pragma unroll
                        for (int n = 0; n < 2; ++n) { const u32x2 xw = xin[mm][bj][n]; const f32x4 v = (f32x4){bf_lo(xw.x), bf_hi(xw.x), bf_lo(xw.y), bf_hi(xw.y)} * rm[mm] + acc[ai][bj][m][n] * ascale;
                            u32x2 w; w.x = cvt_pk_bf16(v[0], v[1]); w.y = cvt_pk_bf16(v[2], v[3]); *(u32x2*)(io + (size_t)row * D + col0 + bj * HALF + n * 16) = w;
                            ss += (v[0] * v[0] + v[1] * v[1]) + (v[2] * v[2] + v[3] * v[3]); }
                    ss += __shfl_xor(ss, 16); ss += __shfl_xor(ss, 32); ssr[ai][m] = ss; }
                asm volatile("" ::: "memory");
            }
        row_ssq_flush(lds, ssr, u.pm, wr, wc, fr, fq, ssq);
    }
};

struct EpiPle {
    static constexpr bool PERM = false, AFTER_DRAIN = false;
    const bf16_t* hin; bf16_t* hout; const bf16_t* proj; const float* ssqp; u64* ssq; LAS unsigned char* lds; float ascale;
    __device__ __forceinline__ void operator()(const f32x4 (&acc)[2][2][4][2], const Unit& u, int wr, int wc, int fr, int fq) const {
        const int row0 = u.pm * BM + wr * 64 + fr, col0 = u.pn * BM + wc * 32 + 4 * fq; float ssr[2][4];
        LAS float* R = (LAS float*)(lds + STAGE_BYTES + 4096);
        { const int tid = (wr * 4 + wc) * 64 + fq * 16 + fr;
          if (tid < 256) { float sq = 0.f;
#pragma unroll
              for (int sl = 0; sl < 8; ++sl) sq += ssqp[(size_t)sl * T + u.pm * BM + tid];
              R[tid] = rsqrtf(sq * (1.f / D) + EPS) * ascale; }
          asm volatile("s_waitcnt lgkmcnt(0)" ::: "memory"); __builtin_amdgcn_s_barrier(); asm volatile("" ::: "memory"); }
#pragma unroll
        for (int ai = 0; ai < 2; ++ai)
#pragma unroll
            for (int m = 0; m < 4; ++m) {
                const int row = row0 + ai * HALF + m * 16; const size_t off = (size_t)row * D + col0; float ss = 0.f; const float ri = R[ai * HALF + wr * 64 + m * 16 + fr];
#pragma unroll
                for (int bj = 0; bj < 2; ++bj)
#pragma unroll
                    for (int n = 0; n < 2; ++n) { const size_t o = off + bj * HALF + n * 16; const u32x2 hw = *(const u32x2*)(hin + o); const u32x2 pw = *(const u32x2*)(proj + o);
                        const f32x4 a = acc[ai][bj][m][n] * ri; f32x4 v;
                        v[0] = bf_lo(hw.x) + bf_lo(pw.x) / (1.f + __expf(-a[0])); v[1] = bf_hi(hw.x) + bf_hi(pw.x) / (1.f + __expf(-a[1]));
                        v[2] = bf_lo(hw.y) + bf_lo(pw.y) / (1.f + __expf(-a[2])); v[3] = bf_hi(hw.y) + bf_hi(pw.y) / (1.f + __expf(-a[3]));
                        u32x2 w; w.x = cvt_pk_bf16(v[0], v[1]); w.y = cvt_pk_bf16(v[2], v[3]); *(u32x2*)(hout + o) = w;
                        ss += (v[0] * v[0] + v[1] * v[1]) + (v[2] * v[2] + v[3] * v[3]); }
                ss += __shfl_xor(ss, 16); ss += __shfl_xor(ss, 32); ssr[ai][m] = ss;
                asm volatile("" ::: "memory");
            }
        row_ssq_flush(lds, ssr, u.pm, wr, wc, fr, fq, ssq);
    }
};

__device__ __forceinline__ float fmax_s(float a, float b) { float d; asm("v_max_f32 %0, %1, %2" : "=v"(d) : "v"(a), "v"(b)); return d; }
__device__ __forceinline__ float fmin_s(float a, float b) { float d; asm("v_min_f32 %0, %1, %2" : "=v"(d) : "v"(a), "v"(b)); return d; }
__device__ __forceinline__ float keyf(float v, unsigned keep, unsigned idx) { return __uint_as_float((__float_as_uint(v) & keep) | idx); }
__device__ __forceinline__ float valf(float k, unsigned keep) { return __uint_as_float(__float_as_uint(k) & keep); }
__device__ __forceinline__ void ins16(float (&L)[16], float x) {
#pragma unroll
    for (int i = 0; i < 16; ++i) { const float hi = fmax_s(L[i], x); x = fmin_s(L[i], x); L[i] = hi; }
}
#define CE(a_, b_) do { const float hi_ = fmax_s((a_), (b_)), lo_ = fmin_s((a_), (b_)); (a_) = hi_; (b_) = lo_; } while (0)
#define SORT16(S) do { CE(S[0], S[1]); CE(S[2], S[3]); CE(S[0], S[2]); CE(S[1], S[3]); CE(S[1], S[2]); CE(S[4], S[5]); CE(S[6], S[7]); CE(S[4], S[6]); CE(S[5], S[7]); CE(S[5], S[6]); CE(S[0], S[4]); CE(S[2], S[6]); CE(S[2], S[4]); CE(S[1], S[5]); CE(S[3], S[7]); CE(S[3], S[5]); CE(S[1], S[2]); CE(S[3], S[4]); CE(S[5], S[6]); CE(S[8], S[9]); CE(S[10], S[11]); CE(S[8], S[10]); CE(S[9], S[11]); CE(S[9], S[10]); CE(S[12], S[13]); CE(S[14], S[15]); CE(S[12], S[14]); CE(S[13], S[15]); CE(S[13], S[14]); CE(S[8], S[12]); CE(S[10], S[14]); CE(S[10], S[12]); CE(S[9], S[13]); CE(S[11], S[15]); CE(S[11], S[13]); CE(S[9], S[10]); CE(S[11], S[12]); CE(S[13], S[14]); CE(S[0], S[8]); CE(S[4], S[12]); CE(S[4], S[8]); CE(S[2], S[10]); CE(S[6], S[14]); CE(S[6], S[10]); CE(S[2], S[4]); CE(S[6], S[8]); CE(S[10], S[12]); CE(S[1], S[9]); CE(S[5], S[13]); CE(S[5], S[9]); CE(S[3], S[11]); CE(S[7], S[15]); CE(S[7], S[11]); CE(S[3], S[5]); CE(S[7], S[9]); CE(S[11], S[13]); CE(S[1], S[2]); CE(S[3], S[4]); CE(S[5], S[6]); CE(S[7], S[8]); CE(S[9], S[10]); CE(S[11], S[12]); CE(S[13], S[14]); } while (0)
#define MERGE16(L, S) do { _Pragma("unroll") for (int i_ = 0; i_ < 16; ++i_) L[i_] = fmax_s(L[i_], S[15 - i_]); \
        _Pragma("unroll") for (int st_ = 8; st_ >= 1; st_ >>= 1) _Pragma("unroll") for (int i_ = 0; i_ < 16; ++i_) if (!(i_ & st_)) CE(L[i_], L[i_ + st_]); } while (0)
struct EpiTopK {
    static constexpr bool PERM = false, AFTER_DRAIN = true;
    unsigned short* eid; float* gate;
    __device__ __forceinline__ void fused(f32x4 (&acc)[2][2][4][2], const Unit& u, int wr, int wc, int fr, int fq, LAS unsigned char* lds, int wid, int lane) const {
        LAS float* SL = (LAS float*)lds;
        LAS unsigned char* TAB = lds + 512 * 272;
        const int tid = wid * 64 + lane, pp = (tid >> 1) & 1, rowl = tid >> 2; int half = tid & 1; asm volatile("" : "+v"(half));
        float OWN[16], SND[16];
#pragma unroll
        for (int ai = 0; ai < 2; ++ai) {
#pragma unroll
            for (int m = 0; m < 4; ++m)
#pragma unroll
                for (int bj = 0; bj < 2; ++bj)
#pragma unroll
                    for (int n = 0; n < 2; ++n) { const int r = 64 * wr + 16 * m + fr, c = 32 * wc + 16 * n + 4 * fq; const int list = r * 4 + bj * 2 + (c >> 6);
                        *(LAS f32x4*)(SL + list * 68 + (c & 63)) = acc[ai][bj][m][n]; }
            asm volatile("s_waitcnt lgkmcnt(0)" ::: "memory"); __builtin_amdgcn_s_barrier(); asm volatile("" ::: "memory");
            float L[16];
            { const LAS float* mine = SL + tid * 68; const int ib = 127 - half * 64;
#pragma unroll
              for (int gI = 0; gI < 4; ++gI) { float S[16];
#pragma unroll
                  for (int k4 = 0; k4 < 4; ++k4) { const f32x4 v = *(const LAS f32x4*)(mine + 16 * gI + 4 * k4);
#pragma unroll
                      for (int e = 0; e < 4; ++e) S[4 * k4 + e] = keyf(v[e], ~127u, (unsigned)(ib - 16 * gI - 4 * k4 - e)); }
                  SORT16(S);
                  if (gI == 0) {
#pragma unroll
                      for (int i = 0; i < 16; ++i) L[i] = S[i]; }
                  else MERGE16(L, S); } }
            float M[16];
#pragma unroll
            for (int i = 0; i < 16; ++i) { const float o = __int_as_float(__builtin_amdgcn_update_dpp(0, __float_as_int(L[15 - i]), 0xB1, 0xF, 0xF, true)); M[i] = fmax_s(L[i], o); }
#pragma unroll
            for (int st = 8; st >= 1; st >>= 1)
#pragma unroll
                for (int i = 0; i < 16; ++i) if (!(i & st)) CE(M[i], M[i + st]);
            if (half == 0) {
#pragma unroll
                for (int i = 0; i < 16; ++i) TAB[((ai * 128 + rowl) * 2 + pp) * 16 + i] = (unsigned char)(127u - (__float_as_uint(M[i]) & 127u)); }
#pragma unroll
            for (int i = 0; i < 16; ++i) { if (ai == 0) { OWN[i] = M[i]; SND[i] = M[i]; } else { OWN[i] = pp ? M[i] : OWN[i]; SND[i] = pp ? SND[i] : M[i]; } }
            asm volatile("s_waitcnt lgkmcnt(0)" ::: "memory"); __builtin_amdgcn_s_barrier(); asm volatile("" ::: "memory");
        }
        {
            const int ai = pp;
            float va[16], vb[16];
#pragma unroll
            for (int i = 0; i < 16; ++i) { const float oth = __int_as_float(__builtin_amdgcn_update_dpp(0, __float_as_int(SND[i]), 0x4E, 0xF, 0xF, true));
                va[i] = valf(pp ? oth : OWN[i], ~127u); vb[i] = valf(pp ? OWN[i] : oth, ~127u); }
            float C[16];
#pragma unroll
            for (int y = 0; y < 16; ++y) C[y] = keyf(va[0] + vb[y], ~255u, (unsigned)(255 - y));
            { float S[16];
              S[0] = keyf(va[1] + vb[0], ~255u, 239u);
              S[1] = keyf(va[1] + vb[1], ~255u, 238u);
              S[2] = keyf(va[1] + vb[2], ~255u, 237u);
              S[3] = keyf(va[1] + vb[3], ~255u, 236u);
              S[4] = keyf(va[1] + vb[4], ~255u, 235u);
              S[5] = keyf(va[1] + vb[5], ~255u, 234u);
              S[6] = keyf(va[1] + vb[6], ~255u, 233u);
              S[7] = keyf(va[1] + vb[7], ~255u, 232u);
              S[8] = keyf(va[2] + vb[0], ~255u, 223u);
              S[9] = keyf(va[2] + vb[1], ~255u, 222u);
              S[10] = keyf(va[2] + vb[2], ~255u, 221u);
              S[11] = keyf(va[2] + vb[3], ~255u, 220u);
              S[12] = keyf(va[2] + vb[4], ~255u, 219u);
              S[13] = keyf(va[3] + vb[0], ~255u, 207u);
              S[14] = keyf(va[3] + vb[1], ~255u, 206u);
              S[15] = keyf(va[3] + vb[2], ~255u, 205u);
              SORT16(S); MERGE16(C, S); }
            { float S[16];
              S[0] = keyf(va[3] + vb[3], ~255u, 204u);
              S[1] = keyf(va[4] + vb[0], ~255u, 191u);
              S[2] = keyf(va[4] + vb[1], ~255u, 190u);
              S[3] = keyf(va[4] + vb[2], ~255u, 189u);
              S[4] = keyf(va[5] + vb[0], ~255u, 175u);
              S[5] = keyf(va[5] + vb[1], ~255u, 174u);
              S[6] = keyf(va[6] + vb[0], ~255u, 159u);
              S[7] = keyf(va[6] + vb[1], ~255u, 158u);
              S[8] = keyf(va[7] + vb[0], ~255u, 143u);
              S[9] = keyf(va[7] + vb[1], ~255u, 142u);
              S[10] = keyf(va[8] + vb[0], ~255u, 127u);
              S[11] = keyf(va[9] + vb[0], ~255u, 111u);
              S[12] = keyf(va[10] + vb[0], ~255u, 95u);
              S[13] = keyf(va[11] + vb[0], ~255u, 79u);
              S[14] = keyf(va[12] + vb[0], ~255u, 63u);
              S[15] = keyf(va[13] + vb[0], ~255u, 47u);
              SORT16(S); MERGE16(C, S); }
            ins16(C, keyf(va[14] + vb[0], ~255u, 31u));
            ins16(C, keyf(va[15] + vb[0], ~255u, 15u));
            asm volatile("s_waitcnt lgkmcnt(0)" ::: "memory");
            if ((tid & 1) == 0) {
                const int token = u.pm * BM + ai * HALF + rowl; const size_t ob = (size_t)token * 128 + u.pn * 16;
                const float vmax = valf(C[0], ~255u); float ex[16], sum = 0.f; int ee[16];
#pragma unroll
                for (int k = 0; k < 16; ++k) { ex[k] = __expf(valf(C[k], ~255u) - vmax); sum += ex[k]; const unsigned code = 255u - (__float_as_uint(C[k]) & 255u);
                    ee[k] = (int)TAB[((ai * 128 + rowl) * 2 + 0) * 16 + (code >> 4)] * 128 + (int)TAB[((ai * 128 + rowl) * 2 + 1) * 16 + (code & 15u)]; }
                const float is = 1.f / sum;
#pragma unroll
                for (int k8 = 0; k8 < 2; ++k8) {
                    *(u32x4*)((bf16_t*)gate + ob + 8 * k8) = (u32x4){cvt_pk_bf16(ex[8 * k8] * is, ex[8 * k8 + 1] * is), cvt_pk_bf16(ex[8 * k8 + 2] * is, ex[8 * k8 + 3] * is), cvt_pk_bf16(ex[8 * k8 + 4] * is, ex[8 * k8 + 5] * is), cvt_pk_bf16(ex[8 * k8 + 6] * is, ex[8 * k8 + 7] * is)};
                    *(u32x4*)(eid + ob + 8 * k8) = (u32x4){(unsigned)ee[8 * k8] | ((unsigned)ee[8 * k8 + 1] << 16), (unsigned)ee[8 * k8 + 2] | ((unsigned)ee[8 * k8 + 3] << 16), (unsigned)ee[8 * k8 + 4] | ((unsigned)ee[8 * k8 + 5] << 16), (unsigned)ee[8 * k8 + 6] | ((unsigned)ee[8 * k8 + 7] << 16)}; }
            }
            asm volatile("s_waitcnt lgkmcnt(0)" ::: "memory"); __builtin_amdgcn_s_barrier(); asm volatile("" ::: "memory");
        }
    }
};
}


namespace att {
typedef short s16x4 __attribute__((ext_vector_type(4)));
typedef float f32x16 __attribute__((ext_vector_type(16)));
constexpr int KVBLK = 64, SHM_V = 8192, SHM_KN = 8192, SHM_KR = 4096;
constexpr int OFF_KN = 0, OFF_KR = 2 * SHM_KN, OFF_V = OFF_KR + 2 * SHM_KR, OFF_WS = OFF_V + 2 * SHM_V, LDS_NEED = OFF_WS + NWAVES * 64 * 4;
#define KSWZ8(row, chunk) ((row) * 128 + (((chunk) ^ (((row) >> 1) & 7)) << 4))
#define KRSWZ8(row, chunk) ((row) * 64 + (((chunk) ^ (((row) >> 2) & 3)) << 4))
#define SBAR() __builtin_amdgcn_sched_barrier(0)
#define VSWZ8(row, chunk) ((row) * 64 + (((chunk) ^ (((row) >> 2) & 3)) << 4))
__device__ __forceinline__ int crow(int r, int hi) { return (r & 3) + 8 * (r >> 2) + 4 * hi; }
__device__ __forceinline__ unsigned cvtpk(float lo, float hi) { unsigned r; asm volatile("v_cvt_pk_bf16_f32 %0, %1, %2" : "=v"(r) : "v"(lo), "v"(hi)); return r; }
__device__ __forceinline__ float fsub_s(float a, float b) { float d; asm volatile("v_sub_f32 %0, %1, %2" : "=v"(d) : "v"(a), "v"(b)); return d; }
__device__ __forceinline__ float fexp2sub_s(float a, float b) { float d; asm volatile("v_sub_f32 %0, %1, %2\n\tv_exp_f32 %0, %0" : "=v"(d) : "v"(a), "v"(b)); return d; }
__device__ __forceinline__ float fmax3_s(float a, float b, float c) { float d; asm volatile("v_max3_f32 %0, %1, %2, %3" : "=v"(d) : "v"(a), "v"(b), "v"(c)); return d; }
__device__ __forceinline__ float fadd_s(float a, float b) { float d; asm volatile("v_add_f32 %0, %1, %2" : "=v"(d) : "v"(a), "v"(b)); return d; }
__device__ __forceinline__ void mask_half(f32x16& p, int dq) {
    const float NEG = -__builtin_inff();
#pragma unroll
    for (int r = 0; r < 16; ++r) { const int c = (r & 3) + 8 * (r >> 2); if (dq - c < 0) p[r] = NEG; }
}
template <int KB> __device__ __forceinline__ void attn_tile(f32x16* o, const char* lds, const int (&kn)[4], const int (&kr)[2], const int (&vr)[2], const v8i32* qr8, float& m_reg, float& l_reg,
                                                             bool first, bool msk, int dq, int hi, int r32, float* al_l) {
    f32x16 p0, p1; v4i32 pa_lo, pa_hi; v8i32 f0, f1, f2, g0, g1, g2;
    int sk_ = 0x7a7a7a7a, sq_ = 0x77777777; asm volatile("" : "+v"(sk_), "+v"(sq_));
#define K_LD8N(F, s_, H) do { const v4i32 lo_ = *reinterpret_cast<const v4i32*>(lds + kn[2 * (s_)] + (OFF_KN + KB * SHM_KN + (H) * 4096)), hi2_ = *reinterpret_cast<const v4i32*>(lds + kn[2 * (s_) + 1] + (OFF_KN + KB * SHM_KN + (H) * 4096)); \
        F = __builtin_shufflevector(lo_, hi2_, 0, 1, 2, 3, 4, 5, 6, 7); } while (0)
#define K_LD8R(F, H) do { const v4i32 lo_ = *reinterpret_cast<const v4i32*>(lds + kr[0] + (OFF_KR + KB * SHM_KR + (H) * 2048)), hi2_ = *reinterpret_cast<const v4i32*>(lds + kr[1] + (OFF_KR + KB * SHM_KR + (H) * 2048)); \
        F = __builtin_shufflevector(lo_, hi2_, 0, 1, 2, 3, 4, 5, 6, 7); } while (0)
#define QK0(P, F, Q) asm volatile("v_mfma_scale_f32_32x32x64_f8f6f4 %0, %1, %2, 0, %3, %4 op_sel_hi:[0,0,0]" : "=&v"(P) : "v"(F), "v"(Q), "v"(sk_), "v"(sq_))
#define QKA(P, F, Q) asm volatile("v_mfma_scale_f32_32x32x64_f8f6f4 %0, %1, %2, %0, %3, %4 op_sel_hi:[0,0,0]" : "+v"(P) : "v"(F), "v"(Q), "v"(sk_), "v"(sq_))
    K_LD8N(f0, 0, 0); K_LD8N(f1, 1, 0); K_LD8R(f2, 0); SBAR(); __builtin_amdgcn_s_setprio(1);
    K_LD8N(g0, 0, 1); SBAR(); QK0(p0, f0, qr8[0]); SBAR();
    K_LD8N(g1, 1, 1); SBAR(); QKA(p0, f1, qr8[1]); SBAR();
    K_LD8R(g2, 1);    SBAR(); QKA(p0, f2, qr8[2]); SBAR();
    QK0(p1, g0, qr8[0]); asm volatile("s_nop 7" ::: "memory"); SBAR();
    __builtin_amdgcn_s_setprio(0);
    if (msk) mask_half(p0, dq);
    float m0 = fmax3_s(p0[0], p0[1], p0[2]);
#pragma unroll
    for (int r = 3; r < 15; r += 2) m0 = fmax3_s(m0, p0[r], p0[r + 1]);
    m0 = fmax3_s(m0, p0[15], p0[15]);
    float psa = 0.f, psb = 0.f; const float mcur = m_reg; const float mc6 = mcur - 6.f;
#define PK8(P, OUT) do { _Pragma("unroll") for (int w_ = 0; w_ < 4; ++w_) { int x_ = __builtin_amdgcn_cvt_pk_fp8_f32(P[4 * w_], P[4 * w_ + 1], 0, false); \
        OUT[w_] = __builtin_amdgcn_cvt_pk_fp8_f32(P[4 * w_ + 2], P[4 * w_ + 3], x_, true); } } while (0)
#define EXP0(r_) do { p0[r_] = fexp2sub_s(p0[r_], mc6); p0[r_ + 1] = fexp2sub_s(p0[r_ + 1], mc6); psa = fadd_s(psa, p0[r_]); psb = fadd_s(psb, p0[r_ + 1]); } while (0)
#define EXP1(r_) do { p1[r_] = fexp2sub_s(p1[r_], mn6); p1[r_ + 1] = fexp2sub_s(p1[r_ + 1], mn6); psa = fadd_s(psa, p1[r_]); psb = fadd_s(psb, p1[r_ + 1]); } while (0)
    EXP0(0); EXP0(2); EXP0(4); SBAR();
    QKA(p1, g1, qr8[1]); SBAR(); EXP0(6); EXP0(8); EXP0(10); SBAR();
    QKA(p1, g2, qr8[2]); SBAR(); EXP0(12); EXP0(14); PK8(p0, pa_lo);
    asm volatile("s_nop 15\n\ts_nop 15\n\ts_nop 15" ::: "memory"); SBAR();
    if (msk) mask_half(p1, dq - 32);
    float pmax = fmax3_s(p1[0], p1[1], m0);
#pragma unroll
    for (int r = 2; r < 16; r += 2) pmax = fmax3_s(pmax, p1[r], p1[r + 1]);
    { auto rr = __builtin_amdgcn_permlane32_swap(__float_as_uint(pmax), __float_as_uint(pmax), false, false); pmax = fmaxf(__uint_as_float(rr[0]), __uint_as_float(rr[1])); }
    float alpha = 1.f;
    if (__builtin_expect(first || !__all(pmax - mcur <= 2.f), 0)) {
        const float dl = first ? pmax - mcur : fmaxf(pmax - mcur, 0.f); const float f = __builtin_amdgcn_exp2f(-dl);
        alpha = first ? 0.f : f; m_reg = mcur + dl; psa = fminf(psa, 3.0e38f) * f; psb = fminf(psb, 3.0e38f) * f;
#pragma unroll
        for (int r = 0; r < 16; ++r) p0[r] = fminf(p0[r], 3.0e38f) * f;
        PK8(p0, pa_lo);
        if (hi == 0) al_l[r32] = alpha; asm volatile("s_waitcnt lgkmcnt(0)" ::: "memory");
#pragma unroll
        for (int d_ = 0; d_ < 4; ++d_)
#pragma unroll
            for (int r = 0; r < 16; ++r) o[d_][r] *= al_l[crow(r, hi)];
    }
    const float mn6 = m_reg - 6.f;
    EXP1(0); EXP1(2); EXP1(4); EXP1(6); EXP1(8); EXP1(10); EXP1(12); EXP1(14);
    PK8(p1, pa_hi);
    const v8i32 pa8 = __builtin_shufflevector(pa_lo, pa_hi, 0, 1, 2, 3, 4, 5, 6, 7);
    int sp_ = 0x79797979, sv_ = 0x7a7a7a7a; asm volatile("" : "+v"(sp_), "+v"(sv_));
#define V_LD8(F, d0) do { const v4i32 lo_ = *reinterpret_cast<const v4i32*>(lds + vr[0] + (OFF_V + KB * SHM_V + (d0) * 2048)), hi2_ = *reinterpret_cast<const v4i32*>(lds + vr[1] + (OFF_V + KB * SHM_V + (d0) * 2048)); \
        F = __builtin_shufflevector(lo_, hi2_, 0, 1, 2, 3, 4, 5, 6, 7); } while (0)
#define PVM(d0, F) asm volatile("v_mfma_scale_f32_32x32x64_f8f6f4 %0, %1, %2, %0, %3, %4 op_sel_hi:[0,0,0]" : "+v"(o[d0]) : "v"(pa8), "v"(F), "v"(sp_), "v"(sv_))
    V_LD8(f0, 0); V_LD8(f1, 1); SBAR(); __builtin_amdgcn_s_setprio(1);
    V_LD8(f2, 2); SBAR(); PVM(0, f0); SBAR();
    V_LD8(g0, 3); SBAR(); PVM(1, f1); SBAR();
    PVM(2, f2); SBAR(); PVM(3, g0); SBAR();
    __builtin_amdgcn_s_setprio(0);
    float ps = psa + psb;
    { auto rr = __builtin_amdgcn_permlane32_swap(__float_as_uint(ps), __float_as_uint(ps), false, false); ps = __uint_as_float(rr[0]) + __uint_as_float(rr[1]); }
    l_reg = l_reg * alpha + ps * (1.f / 64.f);
#undef K_LD8N
#undef K_LD8R
#undef QK0
#undef QKA
#undef EXP0
#undef EXP1
#undef PK8
#undef V_LD8
#undef PVM
}
__device__ __forceinline__ void attn_unit(int b, int h, int qb, const bf16_t* Qm, const bf16_t* KVm, const bf16_t* KRm, bf16_t* Om, char* lds) {
    const int tid = threadIdx.x, wid = __builtin_amdgcn_readfirstlane(tid >> 6), lane = tid & 63, r32 = lane & 31, hi = lane >> 5;
    const size_t rowbase = (size_t)b * SEQ; const int q0 = qb * 256;
    v8i32 qr8[3];
    { const unsigned char* Qw = (const unsigned char*)Qm + (rowbase + q0 + wid * 32 + r32) * NQ + h * QKD + hi * 32;
#pragma unroll
      for (int s_ = 0; s_ < 3; ++s_) { const v4i32 lo_ = *reinterpret_cast<const v4i32*>(Qw + s_ * 64), hi2_ = *reinterpret_cast<const v4i32*>(Qw + s_ * 64 + 16); qr8[s_] = __builtin_shufflevector(lo_, hi2_, 0, 1, 2, 3, 4, 5, 6, 7); } }
    const int NT = (q0 + 256) / KVBLK;
    const int qlo = q0 + wid * 32, qm = qlo + r32 - 4 * hi;
    float* wsf = (float*)(lds + OFF_WS) + wid * 64; float* li_l = wsf; float* al_l = wsf + 32;
    float m_reg = 0.f, l_reg = 0.f; f32x16 o[4] = {};
    int kn[4], kr[2];
#pragma unroll
    for (int q_ = 0; q_ < 4; ++q_) kn[q_] = KSWZ8(r32, 4 * (q_ >> 1) + 2 * hi + (q_ & 1));
    kr[0] = KRSWZ8(r32, 2 * hi); kr[1] = KRSWZ8(r32, 2 * hi + 1);
    int vr[2]; vr[0] = VSWZ8(r32, 2 * hi); vr[1] = VSWZ8(r32, 2 * hi + 1);
    const unsigned char* Kb8 = (const unsigned char*)KVm + rowbase * 1536 + h * 128;
    const unsigned char* Vt8 = (const unsigned char*)KVm + 48 * MiB + ((size_t)(b * NH + h) * (SEQ / KVBLK)) * 8192;
    const unsigned char* Rb8 = (const unsigned char*)KRm + rowbase * 64;
    u32x4 st_kn, st_kr, st_v;
#define SLOAD(t) do { int t_ = tid; asm volatile("" : "+v"(t_)); const unsigned tr_ = (unsigned)t_ & 255u; \
        st_v = *reinterpret_cast<const u32x4*>(Vt8 + (size_t)(t) * 8192 + (unsigned)t_ * 16u); \
        st_kn = *reinterpret_cast<const u32x4*>(Kb8 + (size_t)(t) * (KVBLK * 1536) + ((unsigned)t_ >> 3) * 1536u + ((unsigned)t_ & 7u) * 16u); \
        st_kr = *reinterpret_cast<const u32x4*>(Rb8 + (size_t)(t) * (KVBLK * 64) + tr_ * 16u); } while (0)
#define SWRITE(bf) do { int t_ = tid; asm volatile("" : "+v"(t_)); const int tr_ = t_ & 255; \
        *(u32x4*)(lds + OFF_V + (bf) * SHM_V + VSWZ8(t_ >> 2, t_ & 3)) = st_v; \
        *(u32x4*)(lds + OFF_KN + (bf) * SHM_KN + KSWZ8(t_ >> 3, t_ & 7)) = st_kn; \
        *(u32x4*)(lds + OFF_KR + (bf) * SHM_KR + KRSWZ8(tr_ >> 2, tr_ & 3)) = st_kr; } while (0)
#define VMW() asm volatile("s_waitcnt vmcnt(0)" ::: "memory")
#define STEP(t, KB, NB) do { const int kb_ = (t) * KVBLK; SBAR(); \
        attn_tile<KB>(o, lds, kn, kr, vr, qr8, m_reg, l_reg, (t) == 0, kb_ + KVBLK - 1 > qlo, qm - kb_, hi, r32, al_l); \
        if ((t) + 1 < NT) { VMW(); SWRITE(NB); SBAR(); if ((t) + 2 < NT) SLOAD((t) + 2); } \
        __syncthreads(); } while (0)
    SLOAD(0); VMW(); SWRITE(0); SBAR(); SLOAD(1);
    __syncthreads();
    for (int t = 0; t < NT; t += 2) { STEP(t, 0, 1); STEP(t + 1, 1, 0); }
    if (hi == 0) li_l[r32] = l_reg; asm volatile("s_waitcnt lgkmcnt(0)" ::: "memory");
    int hi_e = hi; asm volatile("" : "+v"(hi_e));
    unsigned char* Ow = (unsigned char*)Om + (rowbase + q0 + wid * 32) * 2560 + 1024 + h * 128 + (size_t)(4 * hi_e) * 2560 + r32;
#pragma unroll
    for (int r = 0; r < 16; ++r) { const int orow = (r & 3) + 8 * (r >> 2); const float rl = 32.f * __builtin_amdgcn_rcpf(li_l[orow + 4 * hi_e]);
#pragma unroll
        for (int d0 = 0; d0 < 4; ++d0) { const float v = o[d0][r] * rl; const float v1 = __shfl_down(v, 1), v2 = __shfl_down(v, 2), v3 = __shfl_down(v, 3);
            if ((r32 & 3) == 0) { int w = __builtin_amdgcn_cvt_pk_fp8_f32(v, v1, 0, false); w = __builtin_amdgcn_cvt_pk_fp8_f32(v2, v3, w, true); *(unsigned*)(Ow + orow * 2560 + d0 * 32) = (unsigned)w; } } }
    __syncthreads();
#undef SLOAD
#undef SWRITE
#undef VMW
#undef STEP
}
#undef KSWZ8
#undef KRSWZ8
#undef VSWZ8
#undef SBAR
}


#define XB_TMO      128
#define XB_XCNT(j)  (256  + 64 * (j))
#define XB_XSUB(j)  (1280 + 64 * (j))
#define XB_XGEN(j)  (2304 + 64 * (j))
#define XB_TOP      3328
#define XB_TOPGEN   3392
#define XCD_BAR_WORDS 3456
#define XB_SPIN_CAP (1u << 18)
__device__ __forceinline__ unsigned xb_ld(unsigned* p)              { return __hip_atomic_load(p, __ATOMIC_RELAXED, __HIP_MEMORY_SCOPE_AGENT); }
__device__ __forceinline__ unsigned xb_add(unsigned* p, unsigned v) { return __hip_atomic_fetch_add(p, v, __ATOMIC_RELAXED, __HIP_MEMORY_SCOPE_AGENT); }
__device__ __forceinline__ unsigned xb_xcc_id() { return (unsigned)__builtin_amdgcn_s_getreg((3 << 11) | 20) & 0xFu; }
#define XB_SPIN(cond, bar) do { unsigned _sp = 0; while (cond) { __builtin_amdgcn_s_sleep(1); \
    if ((++_sp & 255u) == 0u) { if (xb_ld(&(bar)[XB_TMO])) break; if (_sp > XB_SPIN_CAP) { atomicAdd(&(bar)[XB_TMO], 1u); break; } } } } while (0)
struct XcdBarrier { unsigned* bar; unsigned x; volatile LAS unsigned* st; };
__device__ __forceinline__ XcdBarrier xcd_barrier_post(unsigned* bar, volatile LAS unsigned* st) {
    XcdBarrier b; b.bar = bar; b.x = xb_xcc_id(); b.st = st;
    if (threadIdx.x == 0) (void)xb_add(&bar[XB_XCNT(b.x)], 1u);
    return b;
}
__device__ __forceinline__ void xcd_barrier_complete(unsigned* bar, unsigned x, unsigned& nloc, unsigned& nx) {
    const unsigned G = gridDim.x * gridDim.y * gridDim.z;
    unsigned sum, cnt, mine, sp = 0u;
    for (;;) {
        sum = 0u; cnt = 0u; mine = 0u;
#pragma unroll
        for (unsigned j = 0; j < 16; ++j) { const unsigned c = xb_ld(&bar[XB_XCNT(j)]); sum += c; cnt += (c > 0u) ? 1u : 0u; mine = (j == x) ? c : mine; }
        if (sum == G) break;
        __builtin_amdgcn_s_sleep(1);
        if ((++sp & 255u) == 0u) { if (xb_ld(&bar[XB_TMO])) break; if (sp > XB_SPIN_CAP) { atomicAdd(&bar[XB_TMO], 1u); break; } }
    }
    nloc = mine > 0u ? mine : 1u; nx = cnt > 0u ? cnt : 1u;
}
__device__ __forceinline__ void xcd_barrier(const XcdBarrier& b) {
    asm volatile("s_waitcnt vmcnt(0)" ::: "memory");
    __syncthreads();
    if (threadIdx.x == 0) {
        unsigned* bar = b.bar;
        __builtin_amdgcn_s_waitcnt(0);
        unsigned nloc = b.st[0], nx = b.st[1];
        if (nloc == 0u) { xcd_barrier_complete(bar, b.x, nloc, nx); b.st[0] = nloc; b.st[1] = nx; }
        const unsigned old = xb_add(&bar[XB_XSUB(b.x)], 1u);
        const unsigned gen = old / nloc;
        if (old + 1u == (gen + 1u) * nloc) {
            __builtin_amdgcn_fence(__ATOMIC_RELEASE, "agent");
            asm volatile("s_waitcnt vmcnt(0)" ::: "memory");
            const unsigned og = xb_add(&bar[XB_TOP], 1u);
            const unsigned tg = og / nx;
            if (og + 1u == (tg + 1u) * nx) xb_add(&bar[XB_TOPGEN], 1u);
            else XB_SPIN(xb_ld(&bar[XB_TOPGEN]) == tg, bar);
            __builtin_amdgcn_fence(__ATOMIC_ACQUIRE, "agent");
            xb_add(&bar[XB_XGEN(b.x)], 1u);
            asm volatile("s_waitcnt vmcnt(0)" ::: "memory");
        } else {
            XB_SPIN(xb_ld(&bar[XB_XGEN(b.x)]) == gen, bar);
            __builtin_amdgcn_fence(__ATOMIC_ACQUIRE, "agent");
            asm volatile("s_waitcnt vmcnt(0)" ::: "memory");
        }
    }
    __syncthreads();
}

struct Args {
    const float *x, *p; const int* positions; const float *mix_g, *w_in, *pool_w, *pool_scale, *q_g, *w_uq, *kv_g, *w_ukv, *w_o, *ffn_g, *peer_wq, *sub_keys, *peer_u, *peer_v, *ple_g, *ple_wg, *ple_wp, *final_g;
    float* out; unsigned char* ws; int ph_lo, ph_hi;
};

template <class Map> __device__ __forceinline__ void transpose_item(const float* W, int ldw, const float* kscale, bf16_t* WT, int ldt, LAS float* scr, int k0, int n0, int lane, Map map) {
    const int ns = map(n0 + (lane & 31));
#pragma unroll
    for (int i = 0; i < 32; ++i) { const int kk = 2 * i + (lane >> 5); float v = ns >= 0 ? __builtin_nontemporal_load(W + (size_t)(k0 + kk) * ldw + ns) : 0.f; if (kscale) v *= kscale[k0 + kk]; scr[kk * 33 + (lane & 31)] = v; }
    LDS_WAIT(); asm volatile("" ::: "memory");
    const int c = lane & 7;
#pragma unroll
    for (int j = 0; j < 4; ++j) { const int n = (lane >> 3) + 8 * j; const LAS float* s = scr + (8 * c) * 33 + n;
        u32x4 o; o.x = cvt_pk_bf16(s[0 * 33], s[1 * 33]); o.y = cvt_pk_bf16(s[2 * 33], s[3 * 33]); o.z = cvt_pk_bf16(s[4 * 33], s[5 * 33]); o.w = cvt_pk_bf16(s[6 * 33], s[7 * 33]);
        *(u32x4*)(WT + (size_t)(n0 + n) * ldt + k0 + 8 * c) = o; }
    LDS_WAIT(); asm volatile("" ::: "memory");
}
template <class Map> __device__ __forceinline__ void transpose_item_fp8(const float* W, int ldw, const float* kscale, float wscale, unsigned char* WT, int ldt, LAS float* scr, int k0, int n0, int lane, Map map) {
    const int ns = map(n0 + (lane & 31));
#pragma unroll
    for (int i = 0; i < 32; ++i) { const int kk = 2 * i + (lane >> 5); scr[kk * 33 + (lane & 31)] = __builtin_nontemporal_load(W + (size_t)(k0 + kk) * ldw + ns) * (kscale ? kscale[k0 + kk] : 1.f) * wscale; }
    LDS_WAIT(); asm volatile("" ::: "memory");
    const int c = lane & 7;
#pragma unroll
    for (int j = 0; j < 4; ++j) { const int n = (lane >> 3) + 8 * j; const LAS float* sp = scr + (8 * c) * 33 + n;
        int w0 = __builtin_amdgcn_cvt_pk_fp8_f32(sp[0 * 33], sp[1 * 33], 0, false); w0 = __builtin_amdgcn_cvt_pk_fp8_f32(sp[2 * 33], sp[3 * 33], w0, true);
        int w1 = __builtin_amdgcn_cvt_pk_fp8_f32(sp[4 * 33], sp[5 * 33], 0, false); w1 = __builtin_amdgcn_cvt_pk_fp8_f32(sp[6 * 33], sp[7 * 33], w1, true);
        *(u32x2*)(WT + (size_t)(n0 + n) * ldt + k0 + 8 * c) = (u32x2){(unsigned)w0, (unsigned)w1}; }
    LDS_WAIT(); asm volatile("" ::: "memory");
}
__device__ __forceinline__ int rope_perm(int j) { return (j & 1) ? 32 + (j >> 1) : (j >> 1); }

__device__ __forceinline__ void p0_prologue(const Args& a, LAS unsigned char* lds, int vcu, int G, int tid, int lane, int wave) {
    unsigned char* ws = a.ws;
    const int gw = vcu * NWAVES + wave, NGW = G * NWAVES;
    const int gt = vcu * NTHR + tid, NGT = G * NTHR;
    { u64* st = (u64*)(ws + WS_CTL); for (int i = gt; i < 5 * T; i += NGT) st[i] = 0ull; }
    { bf16_t* XN = (bf16_t*)(ws + WS_AB); float* RMS = (float*)(ws + WS_CTL + 5 * (size_t)T * 8 + 4096);
      for (int r = gw; r < T; r += NGW) { const f32x4* xr = (const f32x4*)(a.x + (size_t)r * D) + lane; f32x4 v[8]; float s = 0.f;
#pragma unroll
          for (int j = 0; j < 8; ++j) { v[j] = __builtin_nontemporal_load(xr + 64 * j); s += (v[j][0] * v[j][0] + v[j][1] * v[j][1]) + (v[j][2] * v[j][2] + v[j][3] * v[j][3]); }
          const float q = wave_sum(s) * (1.f / D) + EPS, ri = rsqrtf(q); if (lane == 0) RMS[r] = q * ri;
          u32x2* o = (u32x2*)(XN + (size_t)r * D) + lane;
#pragma unroll
          for (int j = 0; j < 8; ++j) { u32x2 w; w.x = cvt_pk_bf16(v[j][0] * ri, v[j][1] * ri); w.y = cvt_pk_bf16(v[j][2] * ri, v[j][3] * ri); o[64 * j] = w; } } }
    { u32x2* PB = (u32x2*)(ws + WS_PB); const f32x4* ps = (const f32x4*)a.p;
      for (int i = gt; i < T * DPLE / 4; i += NGT) { const f32x4 v = __builtin_nontemporal_load(ps + i); u32x2 w; w.x = cvt_pk_bf16(v[0], v[1]); w.y = cvt_pk_bf16(v[2], v[3]); PB[i] = w; } }
    { float* RP = (float*)(ws + WS_ROPE);
      for (int i = gt; i < T * 32; i += NGT) { const int r = i >> 5, f = i & 31; const float invf = exp2f(-(float)f * (13.287712379549449f / 32.f));
          const float ang = (float)a.positions[r] * invf; float sn, cs; sincosf(ang, &sn, &cs); RP[(size_t)r * 64 + f] = cs; RP[(size_t)r * 64 + 32 + f] = sn; } }
    { LAS float* scr = (LAS float*)(lds + wave * 16384);
      constexpr int I_IN = 32 * 56, I_UQ = 8 * 72, I_UKV = 8 * 96, I_O = 24 * 64, I_Q = 32 * 64, I_G = 32 * 64, I_P = 4 * 64;
      constexpr int NIT = I_IN + I_UQ + I_UKV + I_O + I_Q + I_G + I_P;
      for (int it = gw; it < NIT; it += NGW) { int r = it;
          if (r < I_IN) { transpose_item(a.w_in, DIN, a.mix_g, (bf16_t*)(ws + WS_WIN), D, scr, (r / 56) * 64, (r % 56) * 32, lane,
                [](int n) { return n < 1536 ? n : (n < 1600 ? 1536 + rope_perm(n - 1536) : -1); }); continue; } r -= I_IN;
          if (r < I_UQ) { transpose_item_fp8(a.w_uq, NQ, a.q_g, 1024.f, (unsigned char*)(ws + WS_WUQ), 512, scr, (r / 72) * 64, (r % 72) * 32, lane,
                [](int n) { const int h = n / QKD, c = n % QKD; return c < 128 ? n : h * QKD + 128 + rope_perm(c - 128); }); continue; } r -= I_UQ;
          if (r < I_UKV) { transpose_item_fp8(a.w_ukv, NKV, a.kv_g, 1024.f, (unsigned char*)(ws + WS_WUKV), 512, scr, (r / 96) * 64, (r % 96) * 32, lane,
                [](int n) { return n < 1536 ? (n >> 7) * 256 + (n & 127) : ((n - 1536) >> 7) * 256 + 128 + (n & 127); }); continue; } r -= I_UKV;
          if (r < I_O) { transpose_item_fp8(a.w_o, D, nullptr, 1024.f, (unsigned char*)(ws + WS_WO) + 512, 2560, scr, 512 + (r / 64) * 64, (r % 64) * 32, lane, [](int n) { return n; }); continue; } r -= I_O;
          if (r < I_Q) { transpose_item(a.peer_wq, D, a.ffn_g, (bf16_t*)(ws + WS_WQ), D, scr, (r / 64) * 64, (r % 64) * 32, lane, [](int n) { return n; }); continue; } r -= I_Q;
          if (r < I_G) { transpose_item_fp8(a.ple_wg, D, a.ple_g, 1024.f, (unsigned char*)(ws + WS_WG), D, scr, (r / 64) * 64, (r % 64) * 32, lane, [](int n) { return n; }); continue; } r -= I_G;
          transpose_item(a.ple_wp, D, nullptr, (bf16_t*)(ws + WS_WP), DPLE, scr, (r / 64) * 64, (r % 64) * 32, lane, [](int n) { return n; });
      } }
    { bf16_t* WO = (bf16_t*)(ws + WS_WO); LAS float* pw = (LAS float*)lds;
      for (int i0 = vcu * NTHR; i0 < (DPOOL / 8) * D; i0 += NGT) { const int i = i0 + tid, n = i & (D - 1), k0 = (i0 >> 11) * 8, g = k0 >> 7; float sacc[8];
          __syncthreads();
          for (int j = tid; j < 1024; j += NTHR) pw[j] = a.pool_w[(size_t)k0 * 128 + j] * a.pool_scale[g * 128 + (j & 127)];
          __syncthreads();
#pragma unroll
          for (int c = 0; c < 8; ++c) sacc[c] = 0.f;
#pragma unroll 4
          for (int d = 0; d < 128; d += 4) { const float* wp = a.w_o + (size_t)(g * 128 + d) * D + n; const float w0 = wp[0], w1 = wp[D], w2 = wp[2 * D], w3 = wp[3 * D];
#pragma unroll
              for (int c = 0; c < 8; ++c) { const f32x4 q = *(const LAS f32x4*)(pw + c * 128 + d); sacc[c] += (q[0] * w0 + q[1] * w1) + (q[2] * w2 + q[3] * w3); } }
          u32x4 w; w.x = cvt_pk_bf16(sacc[0] * 1024.f, sacc[1] * 1024.f); w.y = cvt_pk_bf16(sacc[2] * 1024.f, sacc[3] * 1024.f); w.z = cvt_pk_bf16(sacc[4] * 1024.f, sacc[5] * 1024.f); w.w = cvt_pk_bf16(sacc[6] * 1024.f, sacc[7] * 1024.f);
          *(u32x4*)((unsigned char*)WO + (size_t)n * 2560 + k0 * 2) = w; }
      __syncthreads(); }
    { bf16_t* SK = (bf16_t*)(ws + WS_SK);
      for (int i = gt; i < PH * 256 * 256; i += NGT) { const int c = i & 255, r = (i >> 8) & 255, h = i >> 16, pp = r >> 7;
          const float v = ((c >> 7) == pp) ? a.sub_keys[((size_t)(h * 2 + pp) * 128 + (r & 127)) * 128 + (c & 127)] : 0.f; SK[i] = (bf16_t)(cvt_pk_bf16(v, 0.f) & 0xffffu); } }
    { unsigned short* UT = (unsigned short*)(ws + WS_UT); unsigned short* VT = (unsigned short*)(ws + WS_VT); float* SU = (float*)(ws + WS_SU); float* SV = (float*)(ws + WS_SV);
      const int gw = vcu * NWAVES + wave, NGW = G * NWAVES;
#pragma unroll 1
      for (int e = gw; e < NEXP; e += NGW) { const f32x4* ur = (const f32x4*)a.peer_u + (size_t)e * (D / 4) + lane; const f32x4* vr = (const f32x4*)a.peer_v + (size_t)e * (D / 4) + lane;
          f32x4 u[8], v[8];
#pragma unroll
          for (int k = 0; k < 8; ++k) { u[k] = __builtin_nontemporal_load(ur + 64 * k); v[k] = __builtin_nontemporal_load(vr + 64 * k); }
          float mu = 0.f, mv = 0.f;
#pragma unroll
          for (int k = 0; k < 8; ++k) { mu = fmaxf(mu, fmaxf(fmaxf(fabsf(u[k][0]), fabsf(u[k][1])), fmaxf(fabsf(u[k][2]), fabsf(u[k][3])))); mv = fmaxf(mv, fmaxf(fmaxf(fabsf(v[k][0]), fabsf(v[k][1])), fmaxf(fabsf(v[k][2]), fabsf(v[k][3])))); }
#pragma unroll
          for (int o_ = 32; o_ >= 1; o_ >>= 1) { mu = fmaxf(mu, __shfl_xor(mu, o_)); mv = fmaxf(mv, __shfl_xor(mv, o_)); }
          mu = fmaxf(mu, 1e-30f); mv = fmaxf(mv, 1e-30f); const float su = 6.f / mu, sv = 6.f / mv;
          if (lane == 0) { SU[e] = mu * (1.f / 6.f); SV[e] = mv * (1.f / 6.f); }
#pragma unroll
          for (int k = 0; k < 8; ++k) { const size_t o = ((size_t)k * NEXP + e) * 64 + lane;
              unsigned p4 = __builtin_amdgcn_cvt_scalef32_pk_fp4_f32(0u, u[k][0] * su, u[k][1] * su, 1.0f, 0); p4 = __builtin_amdgcn_cvt_scalef32_pk_fp4_f32(p4, u[k][2] * su, u[k][3] * su, 1.0f, 1); UT[o] = (unsigned short)p4;
              p4 = __builtin_amdgcn_cvt_scalef32_pk_fp4_f32(0u, v[k][0] * sv, v[k][1] * sv, 1.0f, 0); p4 = __builtin_amdgcn_cvt_scalef32_pk_fp4_f32(p4, v[k][2] * sv, v[k][3] * sv, 1.0f, 1); VT[o] = (unsigned short)p4; } } }
}

__device__ __forceinline__ float dpp_xor1(float v) { return __builtin_bit_cast(float, __builtin_amdgcn_update_dpp(0, __builtin_bit_cast(int, v), 0xB1, 0xF, 0xF, true)); }
__device__ __forceinline__ float dpp_xor2(float v) { return __builtin_bit_cast(float, __builtin_amdgcn_update_dpp(0, __builtin_bit_cast(int, v), 0x4E, 0xF, 0xF, true)); }
__device__ __forceinline__ void slice_setup(int bx, int G, int wave, int& x, int& wv, int& nwv) { x = bx & 7; const int nlab = (G - x + 7) >> 3; wv = (bx >> 3) * NWAVES + wave; nwv = nlab * NWAVES; }
__device__ __forceinline__ void p7a_upass(const Args& a, int bx, int G, int lane, int wave, LAS unsigned char* lds) {
    int x, wv, nwv; slice_setup(bx, G, wave, x, wv, nwv);
    const int g = lane >> 3, j = lane & 7, r = lane & 15, c = lane >> 4, gsel = r >> 2;
    const char* UT = (const char*)(a.ws + WS_UT); const bf16_t* AB = (const bf16_t*)(a.ws + WS_AB); const unsigned short* EID = (const unsigned short*)(a.ws + WS_EID);
    bf16_t* PART = (bf16_t*)(a.ws + WS_Z); const u64* ssq_ffn = (const u64*)(a.ws + WS_CTL) + 2 * T;
    const int s = x;
    const unsigned goff = (unsigned)g * 32u, soff = (unsigned)(s * (NEXP * 128) + j * 16), xoff = (unsigned)(s * 512 + lane * 8);
    unsigned poff = (unsigned)(16 * gsel + 4 * c) * 2u;
    LAS unsigned char* tile = lds + wave * 16896;
    LAS unsigned char* xim = tile + 16384;
    LAS unsigned char* wr_ = tile + g * 2048;
    const unsigned j16 = (unsigned)j * 16u;
    const LAS unsigned char* ra0 = tile + r * 128 + ((c ^ (r & 7)) * 16);
    const LAS unsigned char* ra1 = tile + r * 128 + (((c ^ (r & 7)) * 16) ^ 64);
    const LAS unsigned char* xr = xim + (r & 3) * 128 + c * 16;
    const float fac = (1.f / 0.75f) * ((r & 2) ? ((r & 1) ? (1.f / 256.f) : (1.f / 32.f)) : ((r & 1) ? 0.25f : 1.f));
    const f32x4 g4 = *(const f32x4*)(a.ffn_g + 256 * s + 4 * lane) * 0.75f;
    int one_e8m0 = 0x7f7f7f7f; asm volatile("" : "+v"(one_e8m0));
    int zero_v = 0; asm volatile("" : "+v"(zero_v));
#define U_TOK(n) __builtin_amdgcn_readfirstlane(wv + ((n) < cnt ? (n) : 0) * nwv)
#define U_IDX(EV, n) do { const char* eb_ = (const char*)EID + (size_t)U_TOK(n) * 256; _Pragma("unroll") for (int q = 0; q < 2; ++q) EV[q] = *(const u32x4*)(eb_ + (goff + q * 16)); } while (0)
#define EXP_ID(EV, i) ((EV[(i) >> 3][((i) >> 1) & 3] >> (((i) & 1) * 16)) & 0xffffu)
#define U_GATHER(W, X, SQ, EV, n) do { const int tk_ = U_TOK(n); \
        _Pragma("unroll") for (int i = 0; i < 16; ++i) W[i] = *(const u32x4*)(UT + (EXP_ID(EV, i) * 128u + soff)); \
        X = *(const u32x2*)((const char*)AB + (size_t)tk_ * (D * 2) + xoff); SQ = *(const u64*)((const char*)ssq_ffn + (size_t)tk_ * 8 + (unsigned)zero_v); } while (0)
#define U_MMA0(ACC, A_, B_) asm volatile("v_mfma_f32_16x16x128_f8f6f4 %0, %1, %2, 0 cbsz:4 blgp:4" : "=&v"(ACC) : "v"(A_), "v"(B_))
#define U_MMA1(ACC, A_, B_) asm volatile("v_mfma_f32_16x16x128_f8f6f4 %0, %1, %2, %0 cbsz:4 blgp:4" : "+v"(ACC) : "v"(A_), "v"(B_))
#define U_PK4(V) ({ unsigned p_ = __builtin_amdgcn_cvt_scalef32_pk_fp4_f32(0u, V[0], V[1], 1.0f, 0); __builtin_amdgcn_cvt_scalef32_pk_fp4_f32(p_, V[2], V[3], 1.0f, 1); })
#define U_UP4(P) ({ const f32x2 a_ = __builtin_amdgcn_cvt_scalef32_pk_f32_fp4(P, 1.0f, 0), b_ = __builtin_amdgcn_cvt_scalef32_pk_f32_fp4(P, 1.0f, 1); (f32x4){a_[0], a_[1], b_[0], b_[1]}; })
#define U_COMPUTE(W, X, SQ, O, O2, n) do { const int t = U_TOK(n); \
        const float ri = rsqrtf((float)SQ * (1.f / 1048576.f) * (1.f / D) + EPS); \
          \
        const f32x4 xv = (f32x4){bf_lo(X.x), bf_hi(X.x), bf_lo(X.y), bf_hi(X.y)} * ri * g4; \
        const unsigned t0_ = U_PK4(xv); const f32x4 r1_ = (xv - U_UP4(t0_)) * 4.f; \
        const unsigned t1_ = U_PK4(r1_); const f32x4 r2_ = (r1_ - U_UP4(t1_)) * 8.f; \
        const unsigned t2_ = U_PK4(r2_); const f32x4 r3_ = (r2_ - U_UP4(t2_)) * 8.f; \
        const unsigned t3_ = U_PK4(r3_); \
        *(LAS unsigned short*)(xim + 2 * lane) = (unsigned short)t0_; *(LAS unsigned short*)(xim + 128 + 2 * lane) = (unsigned short)t1_; \
        *(LAS unsigned short*)(xim + 256 + 2 * lane) = (unsigned short)t2_; *(LAS unsigned short*)(xim + 384 + 2 * lane) = (unsigned short)t3_; \
        _Pragma("unroll") for (int i = 0; i < 16; ++i) *(LAS u32x4*)(wr_ + i * 128 + (j16 ^ (unsigned)((i & 7) * 16))) = W[i]; \
        asm volatile("s_waitcnt lgkmcnt(0)" ::: "memory"); \
        const v4i32 B0 = *(const LAS v4i32*)(xr), B1 = *(const LAS v4i32*)(xr + 64); \
        f32x4 sc[8]; \
          \
        { v4i32 af_[16];                                          \
          _Pragma("unroll") for (int gg = 0; gg < 8; ++gg) { af_[gg] = *(const LAS v4i32*)(ra0 + gg * 2048); af_[8 + gg] = *(const LAS v4i32*)(ra1 + gg * 2048); } \
          __builtin_amdgcn_sched_barrier(0); \
          _Pragma("unroll") for (int gg = 0; gg < 8; ++gg) U_MMA0(sc[gg], af_[gg], B0); \
          _Pragma("unroll") for (int gg = 0; gg < 8; ++gg) U_MMA1(sc[gg], af_[8 + gg], B1); } \
        asm volatile("s_nop 15\n\ts_nop 7" : "+v"(sc[0]), "+v"(sc[1]), "+v"(sc[2]), "+v"(sc[3]), "+v"(sc[4]), "+v"(sc[5]), "+v"(sc[6]), "+v"(sc[7]));     \
          \
        f32x4 kA = sc[0], kB = sc[4]; \
        _Pragma("unroll") for (int gg = 1; gg < 4; ++gg) { const bool m_ = (gsel == gg); _Pragma("unroll") for (int q = 0; q < 4; ++q) { kA[q] = m_ ? sc[gg][q] : kA[q]; kB[q] = m_ ? sc[4 + gg][q] : kB[q]; } } \
        float vA[4], vB[4]; _Pragma("unroll") for (int q = 0; q < 4; ++q) { float pa_ = kA[q] * fac, pb_ = kB[q] * fac; pa_ += dpp_xor1(pa_); pb_ += dpp_xor1(pb_); vA[q] = pa_ + dpp_xor2(pa_); vB[q] = pb_ + dpp_xor2(pb_); } \
        asm volatile("" : "+v"(O), "+v"(O2), "+v"(poff));          \
        O = (u32x2){cvt_pk_bf16(vA[0], vA[1]), cvt_pk_bf16(vA[2], vA[3])}; O2 = (u32x2){cvt_pk_bf16(vB[0], vB[1]), cvt_pk_bf16(vB[2], vB[3])}; \
        if ((r & 3) == 0) { char* pp_ = (char*)PART + ((size_t)s * T + t) * 256; *(u32x2*)(pp_ + poff) = O; *(u32x2*)(pp_ + (poff + 128u)) = O2; } } while (0)
#define U_STEP(Wc, Xc, SQc, Oc, O2c, Wn, Xn, SQn, EVn, EVnn, n) do { \
        U_IDX(EVnn, (n) + 2); __builtin_amdgcn_sched_barrier(0); \
        U_GATHER(Wn, Xn, SQn, EVn, (n) + 1); __builtin_amdgcn_sched_barrier(0); \
        U_COMPUTE(Wc, Xc, SQc, Oc, O2c, n); __builtin_amdgcn_sched_barrier(0); } while (0)
    const int cnt = (T - wv + nwv - 1) / nwv;
    u32x4 wA[16], wB[16], evA[2], evB[2]; u32x2 xA, xB, oA = {0u, 0u}, oB = {0u, 0u}, pA = {0u, 0u}, pB = {0u, 0u}; u64 sqA, sqB;
    U_IDX(evA, 0); U_IDX(evB, 1); __builtin_amdgcn_sched_barrier(0);
    U_GATHER(wA, xA, sqA, evA, 0); __builtin_amdgcn_sched_barrier(0);
#pragma unroll 1
    for (int n = 0; ; n += 2) {
        U_STEP(wA, xA, sqA, oA, pA, wB, xB, sqB, evB, evA, n);
        if (n + 1 >= cnt) break;
        U_STEP(wB, xB, sqB, oB, pB, wA, xA, sqA, evA, evB, n + 1);
        if (n + 2 >= cnt) break;
    }
#undef U_TOK
#undef EXP_ID
#undef U_IDX
#undef U_GATHER
#undef U_MMA0
#undef U_MMA1
#undef U_PK4
#undef U_UP4
#undef U_COMPUTE
#undef U_STEP
}
#define V_PKT(OLD, V, SEL) __builtin_amdgcn_cvt_scalef32_pk_fp4_f32(OLD, V, V, 1.0f, SEL)
#define V_TERMS(V0, WOUT) do { unsigned w_ = V_PKT(0u, V0, 0); const float r1_ = (V0 - __builtin_amdgcn_cvt_scalef32_pk_f32_fp4(w_, 1.0f, 0)[0]) * 4.f; \
        w_ = V_PKT(w_, r1_, 1); const float r2_ = (r1_ - __builtin_amdgcn_cvt_scalef32_pk_f32_fp4(w_, 1.0f, 1)[0]) * 8.f; \
        w_ = V_PKT(w_, r2_, 2); const float r3_ = (r2_ - __builtin_amdgcn_cvt_scalef32_pk_f32_fp4(w_, 1.0f, 2)[0]) * 8.f; \
          \
        unsigned o_ = __builtin_amdgcn_cvt_scalef32_pk_fp4_f32(0u, V0, r1_, 1.0f, 0); o_ = __builtin_amdgcn_cvt_scalef32_pk_fp4_f32(o_, r2_, r3_, 1.0f, 1); WOUT = o_; } while (0)
__device__ __forceinline__ void p7b_apass(const Args& a, int vcu, int G, int tid) {
    const bf16_t* PART = (const bf16_t*)(a.ws + WS_Z); const float* GATE = (const float*)(a.ws + WS_GATE); const int gt = vcu * NTHR + tid, NGT = G * NTHR;
    const unsigned* EID2 = (const unsigned*)(a.ws + WS_EID); const float* SU = (const float*)(a.ws + WS_SU); const float* SV = (const float*)(a.ws + WS_SV);
    unsigned char* AIMG = a.ws + WS_AMIX; float* ASC = (float*)(a.ws + WS_AMIX + 64 * MiB);
    const int l = tid & 63; const unsigned rowo = (unsigned)(16 * (l & 7) + (l >> 3)) * 8u;
    for (int i = gt; i < T * 64; i += NGT) { float h0 = 0.f, h1 = 0.f;
#pragma unroll
        for (int s = 0; s < 8; ++s) { const unsigned w = *(const unsigned*)(PART + (size_t)s * T * 128 + 2 * i); h0 += bf_lo(w); h1 += bf_hi(w); }
        const unsigned gw_ = *((const unsigned*)GATE + i); const f32x2 gt2 = {bf_lo(gw_), bf_hi(gw_)}; const unsigned ee = EID2[i];
        const float x0 = h0 * SU[ee & 0xffffu], x1 = h1 * SU[ee >> 16];
        const float t0 = tanhf(0.7978845608028654f * (x0 + 0.044715f * x0 * x0 * x0)), t1 = tanhf(0.7978845608028654f * (x1 + 0.044715f * x1 * x1 * x1));
        const float a0 = gt2[0] * 0.5f * x0 * (1.f + t0) * SV[ee & 0xffffu], a1 = gt2[1] * 0.5f * x1 * (1.f + t1) * SV[ee >> 16];
        float am = fmaxf(fabsf(a0), fabsf(a1));
#pragma unroll
        for (int o_ = 32; o_ >= 1; o_ >>= 1) am = fmaxf(am, __shfl_xor(am, o_));
        am = fmaxf(am, 1e-30f); const float sa = 4.f / am; unsigned w0, w1;
        { const float v0 = a0 * sa, v1 = a1 * sa; V_TERMS(v0, w0); V_TERMS(v1, w1); }
        const int t = i >> 6; unsigned char* ip = AIMG + (size_t)t * 256 + (rowo >> 2);
        *(unsigned short*)ip = (unsigned short)w0; *(unsigned short*)(ip + 16) = (unsigned short)w1;
        if (l == 0) ASC[t] = am * 0.25f; }
}
#undef V_PKT
#undef V_TERMS
__device__ __forceinline__ void p7c_vpass(const Args& a, int bx, int G, int lane, int wave, LAS unsigned char* lds) {
    int x, wv, nwv; slice_setup(bx, G, wave, x, wv, nwv);
    const int g = lane >> 3, j = lane & 7, n = lane & 15, c = lane >> 4;
    const char* VT = (const char*)(a.ws + WS_VT); bf16_t* AB = (bf16_t*)(a.ws + WS_AB); const unsigned short* EID = (const unsigned short*)(a.ws + WS_EID); const unsigned char* AIMG = a.ws + WS_AMIX; const float* ASC = (const float*)(a.ws + WS_AMIX + 64 * MiB);
    float* ssqp = (float*)(a.ws + WS_GATE); unsigned char* H28 = (unsigned char*)(a.ws + WS_KV); const unsigned goff = (unsigned)g * 32u;
    const int s = x;
    const unsigned soff = (unsigned)(s * (NEXP * 128) + j * 16), hoff = (unsigned)(256 * s + 4 * lane), aoff = (unsigned)(32 * (lane & 3) + (lane >> 2));
    LAS unsigned char* tile = lds + wave * 18432;
    LAS unsigned char* aimg = tile + 16384; LAS float* outb = (LAS float*)(tile + 17408);
    LAS unsigned char* wr_ = tile + g * 128 + ((j ^ g) * 16);
    const LAS unsigned char* rb_ = tile + (32 * c + n) * 128;
    const unsigned sw16 = (unsigned)(n & 7) * 16u;
    const LAS unsigned char* ra_ = aimg + (32 * c + n) * 8;
    int one_e8m0 = 0x7f7f7f7f; asm volatile("" : "+v"(one_e8m0));
    int zero_v = 0; asm volatile("" : "+v"(zero_v));
#define V_TOK(n_) __builtin_amdgcn_readfirstlane(wv + ((n_) < cnt ? (n_) : 0) * nwv)
#define V_IDX(EV, n_) do { const char* eb_ = (const char*)EID + (size_t)V_TOK(n_) * 256; _Pragma("unroll") for (int q = 0; q < 2; ++q) EV[q] = *(const u32x4*)(eb_ + (goff + q * 16)); } while (0)
#define EXP_ID(EV, i) ((EV[(i) >> 3][((i) >> 1) & 3] >> (((i) & 1) * 16)) & 0xffffu)
#define V_GATHER(W, AVw, ASw, HV, EV, n_) do { const int tk_ = V_TOK(n_); \
        _Pragma("unroll") for (int i = 0; i < 16; ++i) W[i] = *(const u32x4*)(VT + (EXP_ID(EV, i) * 128u + soff)); \
        AVw = *(const unsigned*)(AIMG + (size_t)tk_ * 256 + lane * 4); ASw = *(const float*)((const char*)ASC + (size_t)tk_ * 4 + (unsigned)zero_v); \
        HV = *(const u32x2*)((const char*)AB + (size_t)tk_ * (D * 2) + hoff * 2u); } while (0)
#define V_TR(P) __builtin_amdgcn_ds_read_tr4_b64_v2i32((LAS v2i32*)(P))
#define V_MMA(ACC, A_, B_) asm volatile("v_mfma_f32_16x16x128_f8f6f4 %0, %1, %2, 0 cbsz:4 blgp:4" : "=&v"(ACC) : "v"(A_), "v"(B_))
#define V_BATCH(mb0) do { f32x4 dd[8]; v2i32 bl_[8], bh_[8]; \
          \
        _Pragma("unroll") for (int u = 0; u < 8; ++u) { const int mb = (mb0) + u; const LAS unsigned char* p_ = rb_ + (((unsigned)((mb >> 1) * 16)) ^ sw16) + (mb & 1) * 8; bl_[u] = V_TR(p_); bh_[u] = V_TR(p_ + 2048); } \
        __builtin_amdgcn_sched_barrier(0); \
        _Pragma("unroll") for (int u = 0; u < 8; ++u) { const v4i32 B_ = __builtin_shufflevector(bl_[u], bh_[u], 0, 1, 2, 3); V_MMA(dd[u], A_, B_); } \
        asm volatile("s_nop 15\n\ts_nop 7" : "+v"(dd[0]), "+v"(dd[1]), "+v"(dd[2]), "+v"(dd[3]), "+v"(dd[4]), "+v"(dd[5]), "+v"(dd[6]), "+v"(dd[7])); \
        if (c == 0) { _Pragma("unroll") for (int u = 0; u < 8; ++u) outb[16 * ((mb0) + u) + n] = (dd[u][0] + dd[u][1] * 0.25f) + (dd[u][2] * (1.f / 32.f) + dd[u][3] * (1.f / 256.f)); }     \
        __builtin_amdgcn_sched_barrier(0); } while (0)
#define V_COMPUTE(W, AVw, ASw, HV, n_) do { const int t = V_TOK(n_); \
        *(LAS u32x4*)(aimg + lane * 16) = (u32x4){AVw & 0xffffu, 0u, AVw >> 16, 0u};     \
        _Pragma("unroll") for (int i = 0; i < 16; ++i) *(LAS u32x4*)(wr_ + i * 1024) = W[i]; \
        asm volatile("s_waitcnt lgkmcnt(0)" ::: "memory"); \
        const v2i32 al_ = V_TR(ra_), ah_ = V_TR(ra_ + 128); const v4i32 A_ = __builtin_shufflevector(al_, ah_, 0, 1, 2, 3); \
        V_BATCH(0); V_BATCH(8); \
        asm volatile("s_waitcnt lgkmcnt(0)" ::: "memory"); \
        const f32x4 acc4 = *(const LAS f32x4*)(outb + 4 * lane) * ASw; \
        const f32x4 h2 = (f32x4){bf_lo(HV.x), bf_hi(HV.x), bf_lo(HV.y), bf_hi(HV.y)} + acc4; \
        *(u32x2*)((char*)AB + (size_t)t * (D * 2) + hoff * 2u) = (u32x2){cvt_pk_bf16(h2[0], h2[1]), cvt_pk_bf16(h2[2], h2[3])}; \
        { int w8_ = __builtin_amdgcn_cvt_pk_fp8_f32(h2[0] * 32.f, h2[1] * 32.f, 0, false); w8_ = __builtin_amdgcn_cvt_pk_fp8_f32(h2[2] * 32.f, h2[3] * 32.f, w8_, true); *(unsigned*)(H28 + (size_t)t * D + hoff) = (unsigned)w8_; } \
        const float ss = wave_sum_dpp((h2[0] * h2[0] + h2[1] * h2[1]) + (h2[2] * h2[2] + h2[3] * h2[3])); if (lane == 0) ssqp[(size_t)s * T + t] = ss; } while (0)
#define V_STEP(Wc, AVc, ASc, HVc, Wn, AVn, ASn, HVn, EVn, EVnn, n_) do { \
        V_IDX(EVnn, (n_) + 2); __builtin_amdgcn_sched_barrier(0); \
        V_GATHER(Wn, AVn, ASn, HVn, EVn, (n_) + 1); __builtin_amdgcn_sched_barrier(0); \
        V_COMPUTE(Wc, AVc, ASc, HVc, n_); __builtin_amdgcn_sched_barrier(0); } while (0)
    const int cnt = (T - wv + nwv - 1) / nwv;
    u32x4 wA[16], wB[16], evA[2], evB[2]; unsigned avA, avB; float asA, asB; u32x2 hvA, hvB;
    V_IDX(evA, 0); V_IDX(evB, 1); __builtin_amdgcn_sched_barrier(0);
    V_GATHER(wA, avA, asA, hvA, evA, 0); __builtin_amdgcn_sched_barrier(0);
#pragma unroll 1
    for (int n_ = 0; n_ < cnt; n_ += 2) {
        V_STEP(wA, avA, asA, hvA, wB, avB, asB, hvB, evB, evA, n_);
        if (n_ + 1 < cnt) V_STEP(wB, avB, asB, hvB, wA, avA, asA, hvA, evA, evB, n_ + 1);
    }
#undef V_TOK
#undef EXP_ID
#undef V_IDX
#undef V_GATHER
#undef V_TR
#undef V_MMA
#undef V_BATCH
#undef V_COMPUTE
#undef V_STEP
}
__device__ __forceinline__ void p8_final(const Args& a, int vcu, int G, int lane, int wave, float oscale) {
    const int gw = vcu * NWAVES + wave, NGW = G * NWAVES; const u64* ssq = (const u64*)(a.ws + WS_CTL) + 3 * T; const bf16_t* H3 = (const bf16_t*)(a.ws + WS_AMIX);
    f32x4 gv[8];
#pragma unroll
    for (int j = 0; j < 8; ++j) gv[j] = ((const f32x4*)a.final_g)[64 * j + lane];
    for (int r = gw; r < T; r += NGW) { f32x4* orow = (f32x4*)(a.out + (size_t)r * D) + lane; const u32x2* hr = (const u32x2*)(H3 + (size_t)r * D) + lane; const float ri = rsqrtf(ssq_get(ssq + r) * (1.f / D) + EPS) * oscale;
        u32x2 hw[8];
#pragma unroll
        for (int j = 0; j < 8; ++j) hw[j] = __builtin_nontemporal_load(hr + 64 * j);
#pragma unroll
        for (int j = 0; j < 8; ++j) { f32x4 v = {bf_lo(hw[j].x), bf_hi(hw[j].x), bf_lo(hw[j].y), bf_hi(hw[j].y)}; v = v * ri * gv[j]; orow[64 * j] = v; } }
}

__device__ __forceinline__ void p2_pool_kr(const Args& a, int vcu, int G, int lane, int wave) {
    const int gw = vcu * NWAVES + wave, NGW = G * NWAVES; const bf16_t* Z = (const bf16_t*)(a.ws + WS_Z); bf16_t* AM = (bf16_t*)(a.ws + WS_AMIX); bf16_t* KR = (bf16_t*)(a.ws + WS_KR);
    const float* RP = (const float*)(a.ws + WS_ROPE);
    const int grp = lane >> 4, w = 2 << grp;
#pragma unroll 1
    for (int run = gw; run < T / 16; run += NGW) { const int t0 = run * 16, s0 = t0 & (SEQ - 1);
        u32x4 rows[31];
#pragma unroll
        for (int i = 0; i < 31; ++i) { const int dt = i - 15; const int dc = (s0 + dt >= 0) ? dt : -s0;
            rows[i] = *(const u32x4*)(Z + (size_t)(t0 + dc) * DINP + 8 * lane); }
#pragma unroll
        for (int i = 0; i < 15; ++i) { if (s0 + i - 15 < 0) rows[i] = (u32x4){0u, 0u, 0u, 0u}; }
#pragma unroll
        for (int i = 0; i < 16; ++i) {
            float acc[8];
#define ADDROW(R) do { acc[0] += bf_lo(R.x); acc[1] += bf_hi(R.x); acc[2] += bf_lo(R.y); acc[3] += bf_hi(R.y); acc[4] += bf_lo(R.z); acc[5] += bf_hi(R.z); acc[6] += bf_lo(R.w); acc[7] += bf_hi(R.w); } while (0)
            const u32x4 z0 = rows[15 + i]; float x0[8];
            x0[0] = bf_lo(z0.x); x0[1] = bf_hi(z0.x); x0[2] = bf_lo(z0.y); x0[3] = bf_hi(z0.y); x0[4] = bf_lo(z0.z); x0[5] = bf_hi(z0.z); x0[6] = bf_lo(z0.w); x0[7] = bf_hi(z0.w);
#pragma unroll
            for (int e = 0; e < 8; ++e) acc[e] = x0[e];
            ADDROW(rows[14 + i]);
            if (grp >= 1) { ADDROW(rows[13 + i]); ADDROW(rows[12 + i]); }
            if (grp >= 2) { ADDROW(rows[11 + i]); ADDROW(rows[10 + i]); ADDROW(rows[9 + i]); ADDROW(rows[8 + i]); }
            if (grp >= 3) { ADDROW(rows[7 + i]); ADDROW(rows[6 + i]); ADDROW(rows[5 + i]); ADDROW(rows[4 + i]); ADDROW(rows[3 + i]); ADDROW(rows[2 + i]); ADDROW(rows[1 + i]); ADDROW(rows[i]); }
#undef ADDROW
            const int s = s0 + i; const int cnt = (s + 1 < w) ? s + 1 : w; const float ic = 32.f * __builtin_amdgcn_rcpf((float)cnt); u32x4 o;
            o.x = cvt_pk_bf16(acc[0] * ic - 32.f * x0[0], acc[1] * ic - 32.f * x0[1]); o.y = cvt_pk_bf16(acc[2] * ic - 32.f * x0[2], acc[3] * ic - 32.f * x0[3]);
            o.z = cvt_pk_bf16(acc[4] * ic - 32.f * x0[4], acc[5] * ic - 32.f * x0[5]); o.w = cvt_pk_bf16(acc[6] * ic - 32.f * x0[6], acc[7] * ic - 32.f * x0[7]);
            *(u32x4*)((unsigned char*)AM + (size_t)(t0 + i) * 2560 + 16 * lane) = o;
        }
        unsigned kw[8]; float cs[8], sn[8];
#pragma unroll
        for (int j = 0; j < 8; ++j) { const int ti = t0 + 2 * j + (lane >> 5), pr = lane & 31; kw[j] = *(const unsigned*)(Z + (size_t)ti * DINP + 1536 + 2 * pr); cs[j] = RP[(size_t)ti * 64 + pr]; sn[j] = RP[(size_t)ti * 64 + 32 + pr]; }
#pragma unroll
        for (int j = 0; j < 8; ++j) { const int ti = t0 + 2 * j + (lane >> 5), pr = lane & 31; const float x1 = bf_lo(kw[j]), x2 = bf_hi(kw[j]);
            *(unsigned short*)((unsigned char*)KR + (size_t)ti * 64 + 2 * pr) = (unsigned short)__builtin_amdgcn_cvt_pk_fp8_f32(32.f * (x1 * cs[j] - x2 * sn[j]), 32.f * (x2 * cs[j] + x1 * sn[j]), 0, false); }
    }
}

constexpr int N_PHASES = 12;
constexpr float C2 = 0.07216878364870322f * 1.4426950408889634f;
__global__ void __launch_bounds__(NTHR, 2) hymba_fwd(Args a) {
    __builtin_assume(__builtin_amdgcn_workitem_id_y() == 0); __builtin_assume(__builtin_amdgcn_workitem_id_z() == 0);
    extern __shared__ __attribute__((aligned(16))) unsigned char lds_raw[];
    LAS unsigned char* lds = (LAS unsigned char*)lds_raw;
    cg::grid_group grid = cg::this_grid();
    const int tid = threadIdx.x, lane = tid & 63, wave = __builtin_amdgcn_readfirstlane(tid >> 6);
    const int G = gridDim.x; const int bx = blockIdx.x; const int vcu = (G % 8 == 0) ? (bx % 8) * (G / 8) + bx / 8 : bx;
    unsigned char* ws = a.ws;
    u64* ctl = (u64*)(ws + WS_CTL);
    const int lo = a.ph_lo, hi = a.ph_hi;
#define IN(k) (lo <= (k) && (k) < hi)
#if PROBE_PHASE >= 0
    unsigned long long* tsb = (unsigned long long*)(ws + WS_CTL + 5 * (size_t)T * 8);
#define STAMP(k) do { if (bx == 0 && tid == 0) tsb[k] = __builtin_amdgcn_s_memrealtime(); } while (0)
#else
#define STAMP(k) do { } while (0)
#endif
    volatile LAS unsigned* xbst = (volatile LAS unsigned*)(lds + LDS_BYTES - 16);
    if (tid < 4) xbst[tid] = 0u;
    __syncthreads();
    const XcdBarrier xbar = xcd_barrier_post((unsigned*)(ws + WS_BAR), xbst);
#define SEAM(k) do { if (IN(k) && IN((k) + 1)) { if ((k) == 0) grid.sync(); else xcd_barrier(xbar); } STAMP((k) + 1); } while (0)
    STAMP(0);

#define FRESH_IDS() int tid_ = (int)threadIdx.x; asm volatile("" : "+v"(tid_)); const int lane_ = tid_ & 63, wave_ = __builtin_amdgcn_readfirstlane(tid_ >> 6)
    if (IN(0)) { p0_prologue(a, lds, vcu, G, tid, lane, wave); }
    SEAM(0);
    if (IN(1)) {
        pg8::Gemm g{(const bf16_t*)(ws + WS_AB), (const bf16_t*)(ws + WS_WIN), D, D, D, 0}; pg8::StaticOrder S; S.init(T / 256, DINP / 256, G, bx);
        pg8::EpiBf16<DINP, false, true, false, 1> E{(bf16_t*)(ws + WS_Z), nullptr, 0.f, 1.f, ctl, ctl + T, nullptr, lds, (unsigned char*)(ws + WS_EID)};
        pg8::gemm_phase<pg8::EpiBf16<DINP, false, true, false, 1>, pg8::StaticOrder, true, true>(lds, g, S, E);
        const int c0 = (T / 256) * (DINP / 256) - 3 * G;
        pg8::Gemm g2{(const bf16_t*)(ws + WS_PB), (const bf16_t*)(ws + WS_WP), DPLE, DPLE, DPLE, 0}; pg8::TailOrder S2; S2.init(T / 256, D / 256, G, bx, (c0 > 0 && c0 < G) ? c0 : 0);
        pg8::EpiBf16<D, false, false, false> E2{(bf16_t*)(ws + WS_PROJ), nullptr, 0.f, 1.f, nullptr, nullptr, nullptr, lds, nullptr};
        pg8::gemm_phase<pg8::EpiBf16<D, false, false, false>, pg8::TailOrder, true, true>(lds, g2, S2, E2);
    }
    SEAM(1);
    if (IN(2)) {
        { FRESH_IDS(); p2_pool_kr(a, vcu, G, lane_, wave_); }
        { pg8::Gemm g{(const bf16_t*)(ws + WS_EID), (const bf16_t*)(ws + WS_WUQ), 512, 256, 256, 0}; pg8::StaticOrder S; S.init(T / 256, NQ / 256, G, bx);
          pg8::EpiBf16<NQ, true, false, true, 2> E{nullptr, ctl, 1.f / 512.f, C2 * 256.f / (32.f * 1024.f), nullptr, nullptr, (const float*)(ws + WS_ROPE), lds, (unsigned char*)(ws + WS_Q)};
          pg8::gemm_phase<pg8::EpiBf16<NQ, true, false, true, 2>, pg8::StaticOrder, true, true, true>(lds, g, S, E); }
        { pg8::Gemm g{(const bf16_t*)(ws + WS_EID) + 256, (const bf16_t*)(ws + WS_WUKV), 512, 256, 256, 0}; pg8::StaticOrder S; S.init(T / 256, NKV / 256, G, bx);
          pg8::EpiBf16<1536, true, false, false, 3> E{(bf16_t*)(ws + WS_KV + 48 * MiB), ctl + T, 1.f / 512.f, 1.f / (32.f * 1024.f), nullptr, nullptr, nullptr, lds, (unsigned char*)(ws + WS_KV)};
          pg8::gemm_phase<pg8::EpiBf16<1536, true, false, false, 3>, pg8::StaticOrder, true, true, true>(lds, g, S, E); }
    }
    SEAM(2);
    if (IN(3)) {
        const bf16_t* Qm = (const bf16_t*)(ws + WS_Q); const bf16_t* KVm = (const bf16_t*)(ws + WS_KV); const bf16_t* KRm = (const bf16_t*)(ws + WS_KR); bf16_t* Om = (bf16_t*)(ws + WS_AMIX);
        for (int L = vcu; L < NB * NH * 16; L += G) { const int bh = L >> 4, x = L & 15, b = bh / NH, h = bh % NH;
            att::attn_unit(b, h, 31 - x, Qm, KVm, KRm, Om, (char*)lds_raw);
            att::attn_unit(b, h, x, Qm, KVm, KRm, Om, (char*)lds_raw); }
    }
    SEAM(3);
    if (IN(4)) {
        pg8::Gemm g{(const bf16_t*)(ws + WS_AMIX), (const bf16_t*)(ws + WS_WO), 1280, 1280, 1280, 0}; pg8::StaticOrder S; S.init(T / 256, D / 256, G, bx);
        pg8::EpiResF32 E{(bf16_t*)(ws + WS_AB), (const float*)(ws + WS_CTL + 5 * (size_t)T * 8 + 4096), ctl + 2 * T, lds, 1.f / (32.f * 1024.f)};
        pg8::gemm_phase<pg8::EpiResF32, pg8::StaticOrder, true, true, false, 8>(lds, g, S, E);
    }
    SEAM(4);
    if (IN(5)) {
        pg8::Gemm g{(const bf16_t*)(ws + WS_AB), (const bf16_t*)(ws + WS_WQ), D, D, D, 0}; pg8::StaticOrder S; S.init(T / 256, D / 256, G, bx);
        pg8::EpiBf16<D, true, false, false> E{(bf16_t*)(ws + WS_Q), ctl + 2 * T, 1.f / D, 1.f, nullptr, nullptr, nullptr, lds, nullptr};
        pg8::gemm_phase<pg8::EpiBf16<D, true, false, false>, pg8::StaticOrder, true, true>(lds, g, S, E);
    }
    if (IN(5) && IN(6)) { asm volatile("s_waitcnt vmcnt(0) lgkmcnt(0)" ::: "memory"); __builtin_amdgcn_fence(__ATOMIC_ACQ_REL, "workgroup"); __syncthreads(); }
    STAMP(6);
    if (IN(6)) {
        pg8::Gemm g{(const bf16_t*)(ws + WS_Q), (const bf16_t*)(ws + WS_SK), D, 256, 256, 256};
        pg8::EpiTopK E{(unsigned short*)(ws + WS_EID), (float*)(ws + WS_GATE)};
        pg8::StaticOrder So; So.init(T / 256, PH, G, bx);
        for (int i = 0;; ++i) { int upm, upn; { pg8::Unit uu; if (!So.next(i, uu)) break; upm = uu.pm; upn = uu.pn; } pg8::SingleUnit S; S.u0.pm = upm; S.u0.pn = upn;
            pg8::gemm_phase<pg8::EpiTopK, pg8::SingleUnit, false, true, false, 0, true>(lds, g, S, E); }
    }
    SEAM(6);
    if (IN(7)) { FRESH_IDS(); p7a_upass(a, bx, G, lane_, wave_, lds); }
    SEAM(7);
    if (IN(8)) { FRESH_IDS(); p7b_apass(a, vcu, G, tid_); }
    SEAM(8);
    if (IN(9)) { FRESH_IDS(); p7c_vpass(a, bx, G, lane_, wave_, lds); }
    SEAM(9);
    if (IN(10)) {
        pg8::Gemm g{(const bf16_t*)(ws + WS_KV), (const bf16_t*)(ws + WS_WG), D / 2, D / 2, D / 2, 0}; pg8::StaticOrder S; S.init(T / 256, D / 256, G, bx);
        pg8::EpiPle E{(const bf16_t*)(ws + WS_AB), (bf16_t*)(ws + WS_AMIX), (const bf16_t*)(ws + WS_PROJ), (const float*)(ws + WS_GATE), ctl + 3 * T, lds, 1.f / (32.f * 1024.f)};
        pg8::gemm_phase<pg8::EpiPle, pg8::StaticOrder, true, true, true>(lds, g, S, E);
    }
    SEAM(10);
    float oscale = 1.f;
#if PROBE_PHASE >= 0
    { const float frac = (float)(tsb[PROBE_PHASE + 1] - tsb[PROBE_PHASE]) / (float)(tsb[11] - tsb[0]); oscale = 1.f + sqrtf(0.01f + frac); }
#endif
    if (IN(11)) { FRESH_IDS(); p8_final(a, vcu, G, lane_, wave_, oscale); }
#undef FRESH_IDS
#undef IN
#undef SEAM
}

extern "C" void kernel_launch(void* const* d_in, const int* in_sizes, int n_in, void* d_out, int out_size, void* d_ws, size_t ws_size, hipStream_t stream) {
    static int grid = 0;
    if (grid == 0) {
        if (n_in != 21 || out_size != T * D || ws_size < WS_END) { fprintf(stderr, "kernel_launch: unexpected shapes (n_in %d, out %d, ws %zu)\n", n_in, out_size, ws_size); grid = -1; return; }
        int dev = 0, cus = 0, per_cu = 0;
        hipGetDevice(&dev); hipDeviceGetAttribute(&cus, hipDeviceAttributeMultiprocessorCount, dev);
        if (hipFuncSetAttribute((const void*)hymba_fwd, hipFuncAttributeMaxDynamicSharedMemorySize, LDS_BYTES) != hipSuccess) { fprintf(stderr, "kernel_launch: hipFuncSetAttribute failed\n"); grid = -1; return; }
        if (hipOccupancyMaxActiveBlocksPerMultiprocessor(&per_cu, (const void*)hymba_fwd, NTHR, LDS_BYTES) != hipSuccess || per_cu < 1) { fprintf(stderr, "kernel_launch: occupancy query says %d\n", per_cu); grid = -1; (void)hipGetLastError(); return; }
        grid = cus;
    }
    if (grid < 0) return;
    Args a{};
    a.x = (const float*)d_in[0]; a.p = (const float*)d_in[1]; a.positions = (const int*)d_in[2]; a.mix_g = (const float*)d_in[3]; a.w_in = (const float*)d_in[4];
    a.pool_w = (const float*)d_in[5]; a.pool_scale = (const float*)d_in[6]; a.q_g = (const float*)d_in[7]; a.w_uq = (const float*)d_in[8]; a.kv_g = (const float*)d_in[9];
    a.w_ukv = (const float*)d_in[10]; a.w_o = (const float*)d_in[11]; a.ffn_g = (const float*)d_in[12]; a.peer_wq = (const float*)d_in[13]; a.sub_keys = (const float*)d_in[14];
    a.peer_u = (const float*)d_in[15]; a.peer_v = (const float*)d_in[16]; a.ple_g = (const float*)d_in[17]; a.ple_wg = (const float*)d_in[18]; a.ple_wp = (const float*)d_in[19];
    a.final_g = (const float*)d_in[20];
    a.out = (float*)d_out; a.ws = (unsigned char*)d_ws; a.ph_lo = 0; a.ph_hi = N_PHASES;
    if (hipMemsetAsync((char*)d_ws + WS_BAR, 0, XCD_BAR_WORDS * 4, stream) != hipSuccess) { fprintf(stderr, "kernel_launch: memset of the barrier words failed\n"); return; }
    void* args[] = {&a};
    hipError_t e = hipLaunchCooperativeKernel((const void*)hymba_fwd, dim3(grid), dim3(NTHR), args, LDS_BYTES, stream);
    if (e != hipSuccess) fprintf(stderr, "kernel_launch: cooperative launch failed: %s (grid %d)\n", hipGetErrorString(e), grid);
}
```
